# Optimizing an MI355X kernel written in HIP

```python
import math
import jax, jax.numpy as jnp
from jax import lax
import numpy as np

D_MODEL = 1024
BATCH = 32
SEQ = 256
DEPTH = 2
DEC_BATCH = 8
DEC_SEQ = 4096
PAST_LEN = 512

GRID_W = 64
N_EVEN = (DEPTH + 1) // 2
N_ODD = DEPTH // 2
EPS = 1e-6

RET_HEADS = 4
RET_DK = 128
RET_DV = 128
RET_WIDTH = RET_HEADS * RET_DV
RET_CHUNK = 128
RET_BWD_OFFSET = 0.5
CONV_WIDTH = D_MODEL - RET_WIDTH
CONV_K = 3
EVEN_IN = 4 * RET_WIDTH + 4 * CONV_WIDTH
EVEN_MIX = RET_WIDTH + CONV_WIDTH
MLA_HEADS = 8
QK_NOPE = 128
QK_ROPE = 64
V_HEAD = 128
Q_LORA = 384
KV_LORA = 256
MLA_WIDTH = MLA_HEADS * V_HEAD
ODD_IN = Q_LORA + KV_LORA + QK_ROPE + MLA_WIDTH
ROPE_BASE = 10000.0
Q_BLOCK = 128

kernel_name = "hybrid_retconv_mla_diffusion_step"

F32 = jnp.float32


def rms(x, g):
    xf = x.astype(F32)
    y = xf * lax.rsqrt(jnp.mean(xf * xf, axis=-1, keepdims=True) + EPS)
    return (y * g.astype(F32)).astype(x.dtype)


def ada(cvec, w, b):
    m = jax.nn.silu(cvec) @ w + b
    sh, sc, g = jnp.split(m, 3, axis=-1)
    return sh[:, None, :], sc[:, None, :], g[:, None, :]


def ret_log_decay(offset):
    h = jnp.arange(RET_HEADS, dtype=F32)
    return jnp.log(1.0 - 2.0 ** (-5.0 - h - offset))


def retention_scan(q, k, v, log_g, s0):
    B, T, H, _ = q.shape
    C = RET_CHUNK
    N = T // C
    idx = jnp.arange(C, dtype=F32)
    diff = idx[:, None] - idx[None, :]
    mask = jnp.where(diff >= 0, jnp.exp(log_g[:, None, None] * jnp.maximum(diff, 0.0)), 0.0)
    q_dec = jnp.exp(log_g[None, :] * (idx[:, None] + 1.0))
    k_dec = jnp.exp(log_g[None, :] * (C - 1.0 - idx[:, None]))
    c_dec = jnp.exp(log_g * C)

    def chunks(a):
        return a.reshape(B, N, C, H, a.shape[-1]).transpose(1, 0, 2, 3, 4)

    def step(s, qkv):
        qc, kc, vc = qkv
        att = jnp.einsum('bihd,bjhd->bhij', qc, kc) * mask
        o = (jnp.einsum('bhij,bjhe->bihe', att, vc)
             + jnp.einsum('bihd,bhde->bihe', qc, s) * q_dec[None, :, :, None])
        s = s * c_dec[None, :, None, None] + jnp.einsum('bjhd,bjhe->bhde', kc * k_dec[None, :, :, None], vc)
        return s, o

    s_fin, o = lax.scan(step, s0, (chunks(q), chunks(k), chunks(v)))
    return o.transpose(1, 0, 2, 3, 4).reshape(B, T, H, v.shape[-1]), s_fin


def ret_conv_mixer(h, w_in, conv_w, w_out, s_fwd0, s_bwd0):
    B, T, _ = h.shape
    R, Cw = RET_WIDTH, CONV_WIDTH
    p = h @ w_in
    q, k, v, g_a, bg, cg, xh, g_b = jnp.split(
        p, [R, 2 * R, 3 * R, 4 * R, 4 * R + Cw, 4 * R + 2 * Cw, 4 * R + 3 * Cw], axis=-1)
    q = q.reshape(B, T, RET_HEADS, RET_DK).astype(F32)
    k = k.reshape(B, T, RET_HEADS, RET_DK).astype(F32) * (RET_DK ** -0.5)
    v = v.reshape(B, T, RET_HEADS, RET_DV).astype(F32)
    o_f, s_f = retention_scan(q, k, v, ret_log_decay(0.0), s_fwd0)
    o_b, s_b = retention_scan(q[:, ::-1], k[:, ::-1], v[:, ::-1], ret_log_decay(RET_BWD_OFFSET), s_bwd0)
    o = o_f + o_b[:, ::-1]
    o = o * lax.rsqrt(jnp.mean(o * o, axis=-1, keepdims=True) + EPS)
    y_a = o.reshape(B, T, R).astype(h.dtype) * jax.nn.silu(g_a)
    z = cg * xh
    zp = jnp.pad(z, ((0, 0), (1, 1), (0, 0)))
    zc = zp[:, :-2] * conv_w[0] + zp[:, 1:-1] * conv_w[1] + zp[:, 2:] * conv_w[2]
    y_b = jax.nn.silu(g_b) * bg * zc
    return jnp.concatenate([y_a, y_b], axis=-1) @ w_out, s_f, s_b


def _rot(x, ang):
    f = ang.shape[-1]
    cos = jnp.cos(ang)[:, None, :]
    sin = jnp.sin(ang)[:, None, :]
    x1, x2 = x[..., :f], x[..., f:]
    return jnp.concatenate([x1 * cos - x2 * sin, x1 * sin + x2 * cos], axis=-1)


def rope_2d(x):
    T = x.shape[1]
    rows = T // GRID_W
    row = jnp.repeat(jnp.arange(rows, dtype=F32), GRID_W)
    col = jnp.tile(jnp.arange(GRID_W, dtype=F32), rows)
    f = QK_ROPE // 4
    inv = ROPE_BASE ** (-jnp.arange(f, dtype=F32) / f)
    xf = x.astype(F32)
    half = QK_ROPE // 2
    out = jnp.concatenate([_rot(xf[..., :half], row[:, None] * inv),
                           _rot(xf[..., half:], col[:, None] * inv)], axis=-1)
    return out.astype(x.dtype)


def mla_project(h, w_in, qn_g, kvn_g, q_up):
    B, T, _ = h.shape
    q_lat, kv_lat, k_rope, gate = jnp.split(h @ w_in, [Q_LORA, Q_LORA + KV_LORA, Q_LORA + KV_LORA + QK_ROPE], axis=-1)
    q = (rms(q_lat, qn_g) @ q_up).reshape(B, T, MLA_HEADS, QK_NOPE + QK_ROPE)
    ckv = rms(kv_lat, kvn_g)
    return q[..., :QK_NOPE], q[..., QK_NOPE:], ckv, k_rope, gate


def mla_expand(ckv, kv_up):
    B, L, _ = ckv.shape
    kv = (ckv @ kv_up).reshape(B, L, MLA_HEADS, QK_NOPE + V_HEAD)
    return kv[..., :QK_NOPE], kv[..., QK_NOPE:]


def mla_attend(q_nope, q_rope, k_nope, k_rope, v):
    B, T, H, _ = q_nope.shape
    NB = T // Q_BLOCK
    scale = (QK_NOPE + QK_ROPE) ** -0.5

    def blocks(a):
        return a.reshape(B, NB, Q_BLOCK, H, a.shape[-1]).transpose(1, 0, 2, 3, 4)

    def one(qs):
        qn, qr = qs
        s = jnp.einsum('bqhd,bkhd->bhqk', qn, k_nope) + jnp.einsum('bqhr,bkr->bhqk', qr, k_rope)
        pr = jax.nn.softmax(s.astype(F32) * scale, axis=-1).astype(v.dtype)
        return jnp.einsum('bhqk,bkhe->bqhe', pr, v)

    o = lax.map(one, (blocks(q_nope), blocks(q_rope)))
    return o.transpose(1, 0, 2, 3, 4).reshape(B, T, H * V_HEAD)


def mla_context(h, w_in, qn_g, kvn_g, q_up, kv_up, w_out):
    q_nope, q_rope, ckv, k_rope, gate = mla_project(h, w_in, qn_g, kvn_g, q_up)
    k_nope, v = mla_expand(ckv, kv_up)
    o = mla_attend(q_nope, q_rope, k_nope, k_rope, v)
    return (o * jax.nn.silu(gate)) @ w_out, ckv, k_rope


def mla_latent(h, w_in, qn_g, kvn_g, q_up, kv_up, w_out, ctx_ckv, ctx_krope):
    q_nope, q_rope, ckv, k_rope, gate = mla_project(h, w_in, qn_g, kvn_g, q_up)
    q_rope = rope_2d(q_rope)
    k_rope = rope_2d(k_rope[:, :, None, :])[:, :, 0, :]
    k_nope_l, v_l = mla_expand(ckv, kv_up)
    k_nope_c, v_c = mla_expand(ctx_ckv, kv_up)
    k_nope = jnp.concatenate([k_nope_c, k_nope_l], axis=1)
    k_r = jnp.concatenate([ctx_krope, k_rope], axis=1)
    v = jnp.concatenate([v_c, v_l], axis=1)
    o = mla_attend(q_nope, q_rope, k_nope, k_r, v)
    return (o * jax.nn.silu(gate)) @ w_out


def setup_inputs(seed: int = 0) -> dict:
    key = jax.random.key(seed)
    ks = jax.random.split(key, 24)

    def nrm(k, shape, scale):
        return jax.random.normal(k, shape, F32) * scale

    return {
        "x_prompt": nrm(ks[0], (BATCH, SEQ, D_MODEL), 1.0),
        "x_sample": nrm(ks[1], (DEC_BATCH, DEC_SEQ, D_MODEL), 1.0),
        "c": nrm(ks[2], (DEC_BATCH, D_MODEL), 1.0),
        "state_ret_fwd": nrm(ks[3], (DEC_BATCH, N_EVEN, RET_HEADS, RET_DK, RET_DV), 0.5),
        "state_ret_bwd": nrm(ks[4], (DEC_BATCH, N_EVEN, RET_HEADS, RET_DK, RET_DV), 0.5),
        "cache_mla_ckv": nrm(ks[5], (DEC_BATCH, N_ODD, PAST_LEN, KV_LORA), 1.0),
        "cache_mla_krope": nrm(ks[6], (DEC_BATCH, N_ODD, PAST_LEN, QK_ROPE), 1.0),
        "c_ctx": nrm(ks[7], (D_MODEL,), 1.0),
        "ada_w": nrm(ks[8], (DEPTH, D_MODEL, 3 * D_MODEL), 0.5 * D_MODEL ** -0.5),
        "ada_b": nrm(ks[9], (DEPTH, 3 * D_MODEL), 0.02),
        "norm_g": 1.0 + nrm(ks[10], (DEPTH, D_MODEL), 0.02),
        "even_in_w": nrm(ks[11], (N_EVEN, D_MODEL, EVEN_IN), D_MODEL ** -0.5),
        "even_conv_w": nrm(ks[12], (N_EVEN, CONV_K, CONV_WIDTH), CONV_K ** -0.5),
        "even_out_w": nrm(ks[13], (N_EVEN, EVEN_MIX, D_MODEL), EVEN_MIX ** -0.5),
        "odd_in_w": nrm(ks[14], (N_ODD, D_MODEL, ODD_IN), D_MODEL ** -0.5),
        "odd_q_norm_g": 1.0 + nrm(ks[15], (N_ODD, Q_LORA), 0.02),
        "odd_kv_norm_g": 1.0 + nrm(ks[16], (N_ODD, KV_LORA), 0.02),
        "odd_q_up_w": nrm(ks[17], (N_ODD, Q_LORA, MLA_HEADS * (QK_NOPE + QK_ROPE)), Q_LORA ** -0.5),
        "odd_kv_up_w": nrm(ks[18], (N_ODD, KV_LORA, MLA_HEADS * (QK_NOPE + V_HEAD)), KV_LORA ** -0.5),
        "odd_out_w": nrm(ks[19], (N_ODD, MLA_WIDTH, D_MODEL), MLA_WIDTH ** -0.5),
        "final_norm_g": 1.0 + nrm(ks[20], (D_MODEL,), 0.02),
    }


def reference(x_prompt, x_sample, c, state_ret_fwd, state_ret_bwd, cache_mla_ckv, cache_mla_krope, c_ctx,
              ada_w, ada_b, norm_g, even_in_w, even_conv_w, even_out_w, odd_in_w, odd_q_norm_g,
              odd_kv_norm_g, odd_q_up_w, odd_kv_up_w, odd_out_w, final_norm_g):
    xp, xs = x_prompt, x_sample
    B = xp.shape[0]
    new_sf, new_sb, new_ckv, new_kr = [], [], [], []
    for l in range(DEPTH):
        sh_p, sc_p, g_p = ada(c_ctx[None, :], ada_w[l], ada_b[l])
        sh_s, sc_s, g_s = ada(c, ada_w[l], ada_b[l])
        hp = rms(xp, norm_g[l]) * (1.0 + sc_p) + sh_p
        hs = rms(xs, norm_g[l]) * (1.0 + sc_s) + sh_s
        i = l // 2
        if l % 2 == 0:
            zero = jnp.zeros((B, RET_HEADS, RET_DK, RET_DV), F32)
            yp, sf, sb = ret_conv_mixer(hp, even_in_w[i], even_conv_w[i], even_out_w[i], zero, zero)
            ys, _, _ = ret_conv_mixer(hs, even_in_w[i], even_conv_w[i], even_out_w[i],
                                      state_ret_fwd[:, i].astype(F32), state_ret_bwd[:, i].astype(F32))
            new_sf.append(sf.astype(xp.dtype))
            new_sb.append(sb.astype(xp.dtype))
        else:
            yp, ckv, kr = mla_context(hp, odd_in_w[i], odd_q_norm_g[i], odd_kv_norm_g[i],
                                      odd_q_up_w[i], odd_kv_up_w[i], odd_out_w[i])
            ys = mla_latent(hs, odd_in_w[i], odd_q_norm_g[i], odd_kv_norm_g[i], odd_q_up_w[i],
                            odd_kv_up_w[i], odd_out_w[i], cache_mla_ckv[:, i], cache_mla_krope[:, i])
            new_ckv.append(ckv)
            new_kr.append(kr)
        xp = xp + g_p * yp
        xs = xs + g_s * ys
    y_prompt = rms(xp, final_norm_g)
    y_sample = rms(xs, final_norm_g)
    return (y_prompt, y_sample, jnp.stack(new_sf, axis=1), jnp.stack(new_sb, axis=1),
            jnp.stack(new_ckv, axis=1), jnp.stack(new_kr, axis=1))
```

```cpp
#include <hip/hip_runtime.h>
#include <hip/hip_cooperative_groups.h>
#include <cstdio>
#include <cstdint>
namespace cg = cooperative_groups;
namespace pg8 {
#define PG8_LAS __attribute__((address_space(3)))
typedef unsigned short bf16_t;
typedef short bf16x8 __attribute__((ext_vector_type(8)));
typedef float f32x4 __attribute__((ext_vector_type(4)));
typedef unsigned u32x4 __attribute__((ext_vector_type(4)));
constexpr int BM = 256, BK = 64, HALF = 128, HTB = HALF * BK * 2  , STAGE_BYTES = 8 * HTB, NXCD = 8, WGM = 8;

__host__ __device__ __forceinline__ int lds_byte(int r, int c) { const int st = (r >> 4) * 2 + (c >> 5), rr = r & 15, cc = c & 31, ob = rr * 64 + cc * 2; return st * 1024 + (ob ^ (((ob >> 9) & 1) << 5)); }
__host__ __device__ __forceinline__ void stage_rc(int b, int& R, int& C) { const int st = b / 1024, sb = b % 1024, swz = sb ^ (((sb >> 9) & 1) << 5); R = (st >> 1) * 16 + swz / 64; C = (st & 1) * 32 + (swz % 64) / 2; }
__host__ __device__ __forceinline__ int perm32(int rho) { const int n = rho >> 4, i = rho & 15; return 8 * (i >> 2) + 4 * n + (i & 3); }

struct Unit { int pm, pn; };
struct Gemm { const bf16_t* A; const bf16_t* Bt; int M, N, K; };

struct StaticOrder {
    int nM, nN, nwg, G, c;
    __host__ __device__ void init(int M, int N, int G_, int c_) { nM = M / BM; nN = N / BM; nwg = nM * nN; G = G_; c = c_; }
    __host__ __device__ bool next(int i, Unit& u) const {
        const long L = (long)i * G + c; if (L >= nwg) return false;
        int wgid = (int)L; { const int q = nwg / NXCD, r = nwg % NXCD, xcd = wgid % NXCD, off = wgid / NXCD; wgid = (xcd < r ? xcd * (q + 1) : r * (q + 1) + (xcd - r) * q) + off; }
        const int nig = WGM * nN, gid = wgid / nig, fm = gid * WGM, gsz = (nM - fm) < WGM ? (nM - fm) : WGM;
        u.pm = fm + ((wgid % nig) % gsz); u.pn = (wgid % nig) / gsz; return true;
    }
    __device__ __forceinline__ void a_ready(const Unit&) const {}
    __device__ __forceinline__ void done(const Unit&) const {}
};

__device__ __forceinline__ unsigned cvt_pk_bf16(float lo, float hi) { unsigned r; asm volatile("v_cvt_pk_bf16_f32 %0, %1, %2" : "=v"(r) : "v"(lo), "v"(hi)); return r; }
typedef float f32x2 __attribute__((ext_vector_type(2)));
template <class Epi, class Sched, bool ALIGN_EPI = false, bool SP2 = false>
__device__ __forceinline__ void gemm_phase(PG8_LAS unsigned char* lds, const Gemm g, const Sched& S, const Epi& E) {
    const int tid = threadIdx.x, wid = __builtin_amdgcn_readfirstlane(tid >> 6), lane = tid & 63, wr = wid >> 2, wc = wid & 3, fr = lane & 15, fq = lane >> 4;
    const int K = g.K, nt = K / BK;
    unsigned voffA[2], voffB[2];
#pragma unroll
    for (int i = 0; i < 2; ++i) { int R, C; stage_rc(tid * 16 + i * 8192, R, C); const int Rb = Epi::PERM ? ((R & ~31) + perm32(R & 31)) : R;
        voffA[i] = (unsigned)(R * K + C) * 2u; voffB[i] = (unsigned)(Rb * K + C) * 2u; }
    const size_t kstep = (size_t)(BK * 2);
    const size_t hstep = (size_t)HALF * K * 2;
    const size_t tstep = 2 * hstep;
    const unsigned ldsw = (unsigned)wid * 1024u;
    const int aoff = lds_byte(wr * 64 + fr, fq * 8), boff = lds_byte(wc * 32 + fr, fq * 8);
#define PG8_SA(b, h) (((b) * 2 + (h)) * HTB)
#define PG8_SB(b, h) ((4 + (b) * 2 + (h)) * HTB)
#define PG8_STAGE(bufoff, gbase, voff) do { _Pragma("unroll") for (int _i = 0; _i < 2; ++_i) \
        __builtin_amdgcn_global_load_lds((const unsigned*)((const char*)(gbase) + (voff)[_i]), (PG8_LAS unsigned*)(lds + (bufoff) + ldsw + _i * 8192), 16, 0, 0); } while (0)
#define PG8_LDA(dst, b, h) do { _Pragma("unroll") for (int m = 0; m < 4; ++m) _Pragma("unroll") for (int k = 0; k < 2; ++k) dst[m][k] = *(const PG8_LAS bf16x8*)(lds + PG8_SA(b, h) + aoff + m * 2048 + k * 1024); } while (0)
#define PG8_LDB(dst, b, h) do { _Pragma("unroll") for (int n = 0; n < 2; ++n) _Pragma("unroll") for (int k = 0; k < 2; ++k) dst[n][k] = *(const PG8_LAS bf16x8*)(lds + PG8_SB(b, h) + boff + n * 2048 + k * 1024); } while (0)
#define PG8_MMA(ai, bj, At, Bt) do { __builtin_amdgcn_s_setprio(1); _Pragma("unroll") for (int m = 0; m < 4; ++m) _Pragma("unroll") for (int n = 0; n < 2; ++n) _Pragma("unroll") for (int k = 0; k < 2; ++k) \
        acc[ai][bj][m][n] = __builtin_amdgcn_mfma_f32_16x16x32_bf16(Bt[n][k], At[m][k], acc[ai][bj][m][n], 0, 0, 0); __builtin_amdgcn_s_setprio(0); } while (0)
#define PG8_WAIT_V(n) asm volatile("s_waitcnt vmcnt(" #n ")" ::: "memory")
#define PG8_WAIT_L(n) asm volatile("s_waitcnt lgkmcnt(" #n ")" ::: "memory")
#define PG8_BAR __builtin_amdgcn_s_barrier()
#define PG8_SCHED __builtin_amdgcn_sched_barrier(0)
    Unit cur, nxt; int ui = 0;
    if (!S.next(0, cur)) return;
    f32x4 acc[2][2][4][2];
#pragma unroll
    for (int a = 0; a < 2; ++a)
#pragma unroll
        for (int b = 0; b < 2; ++b)
#pragma unroll
            for (int m = 0; m < 4; ++m)
#pragma unroll
                for (int n = 0; n < 2; ++n) acc[a][b][m][n] = (f32x4){0.f, 0.f, 0.f, 0.f};
    bf16x8 At[4][2], B0[2][2], B1[2][2];
    const char* cA = (const char*)g.A + (size_t)cur.pm * tstep; const char* cB = (const char*)g.Bt + (size_t)cur.pn * tstep;
    S.a_ready(cur);
    if constexpr (SP2) {
        PG8_STAGE(PG8_SB(0, 0), cB, voffB); PG8_STAGE(PG8_SB(0, 1), cB + hstep, voffB); PG8_STAGE(PG8_SA(0, 0), cA, voffA); PG8_STAGE(PG8_SA(0, 1), cA + hstep, voffA);
        if (wr == 1) PG8_BAR;
        PG8_WAIT_V(2); PG8_BAR;
        PG8_STAGE(PG8_SB(1, 0), cB + kstep, voffB); PG8_STAGE(PG8_SA(1, 0), cA + kstep, voffA); PG8_STAGE(PG8_SB(1, 1), cB + hstep + kstep, voffB);
        PG8_WAIT_V(6); PG8_BAR;
    } else {
        PG8_STAGE(PG8_SB(0, 0), cB, voffB); PG8_STAGE(PG8_SA(0, 0), cA, voffA); PG8_STAGE(PG8_SB(0, 1), cB + hstep, voffB); PG8_STAGE(PG8_SA(0, 1), cA + hstep, voffA);
        if (wr == 1) PG8_BAR;
        PG8_WAIT_V(4); PG8_BAR;
        PG8_STAGE(PG8_SB(1, 0), cB + kstep, voffB); PG8_STAGE(PG8_SA(1, 0), cA + kstep, voffA); PG8_STAGE(PG8_SB(1, 1), cB + hstep + kstep, voffB);
        PG8_WAIT_V(6); PG8_BAR;
    }
    for (;;) {
        const bool has_next = S.next(ui + 1, nxt);
        const char* nA = has_next ? (const char*)g.A + (size_t)nxt.pm * tstep : cA; const char* nB = has_next ? (const char*)g.Bt + (size_t)nxt.pn * tstep : cB;
        for (int t = 0; t < nt; t += 2) {
            const bool last = (t == nt - 2);
            const char* a1 = cA + (size_t)(t + 1) * kstep;
            const char* a2 = last ? nA : cA + (size_t)(t + 2) * kstep; const char* b2 = last ? nB : cB + (size_t)(t + 2) * kstep;
            const char* a3 = a2 + kstep; const char* b3 = b2 + kstep;
            if (last && has_next) S.a_ready(nxt);
            if constexpr (SP2) {
            PG8_LDB(B0, 0, 0); PG8_LDB(B1, 0, 1); PG8_SCHED; PG8_LDA(At, 0, 0); PG8_STAGE(PG8_SA(1, 1), a1 + hstep, voffA);
            PG8_WAIT_V(8); PG8_WAIT_L(0); PG8_BAR; PG8_MMA(0, 0, At, B0); PG8_MMA(0, 1, At, B1); PG8_BAR; PG8_SCHED;
            PG8_LDA(At, 0, 1); PG8_STAGE(PG8_SB(0, 0), b2, voffB); PG8_STAGE(PG8_SB(0, 1), b2 + hstep, voffB); PG8_STAGE(PG8_SA(0, 0), a2, voffA);
            PG8_WAIT_V(8); PG8_WAIT_L(0); PG8_BAR; PG8_MMA(1, 0, At, B0); PG8_MMA(1, 1, At, B1); PG8_BAR; PG8_SCHED;
            PG8_LDB(B0, 1, 0); PG8_LDB(B1, 1, 1); PG8_SCHED; PG8_LDA(At, 1, 0); PG8_STAGE(PG8_SA(0, 1), a2 + hstep, voffA);
            PG8_WAIT_V(8); PG8_WAIT_L(0); PG8_BAR; PG8_MMA(0, 0, At, B0); PG8_MMA(0, 1, At, B1); PG8_BAR; PG8_SCHED;
            PG8_LDA(At, 1, 1); PG8_STAGE(PG8_SB(1, 0), b3, voffB); PG8_STAGE(PG8_SB(1, 1), b3 + hstep, voffB); PG8_STAGE(PG8_SA(1, 0), a3, voffA);
            PG8_WAIT_V(8); PG8_WAIT_L(0); PG8_BAR; PG8_MMA(1, 0, At, B0); PG8_MMA(1, 1, At, B1); PG8_BAR; PG8_SCHED;
            } else {
            PG8_LDB(B0, 0, 0); PG8_SCHED; PG8_LDA(At, 0, 0); PG8_STAGE(PG8_SA(1, 1), a1 + hstep, voffA);
            PG8_WAIT_L(8); PG8_BAR; PG8_WAIT_L(0); PG8_MMA(0, 0, At, B0); PG8_BAR; PG8_SCHED;
            PG8_LDB(B1, 0, 1); PG8_STAGE(PG8_SB(0, 0), b2, voffB);
            PG8_BAR; PG8_WAIT_L(0); PG8_MMA(0, 1, At, B1); PG8_BAR;
            PG8_LDA(At, 0, 1); PG8_STAGE(PG8_SA(0, 0), a2, voffA);
            PG8_BAR; PG8_WAIT_L(0); PG8_MMA(1, 0, At, B0); PG8_BAR; PG8_SCHED;
            PG8_STAGE(PG8_SB(0, 1), b2 + hstep, voffB);
            PG8_WAIT_V(6); PG8_BAR; PG8_MMA(1, 1, At, B1); PG8_BAR;
            PG8_LDB(B0, 1, 0); PG8_SCHED; PG8_LDA(At, 1, 0); PG8_STAGE(PG8_SA(0, 1), a2 + hstep, voffA);
            PG8_WAIT_L(8); PG8_BAR; PG8_WAIT_L(0); PG8_MMA(0, 0, At, B0); PG8_BAR; PG8_SCHED;
            PG8_LDB(B1, 1, 1); PG8_STAGE(PG8_SB(1, 0), b3, voffB);
            PG8_BAR; PG8_WAIT_L(0); PG8_MMA(0, 1, At, B1); PG8_BAR;
            PG8_LDA(At, 1, 1); PG8_STAGE(PG8_SA(1, 0), a3, voffA);
            PG8_BAR; PG8_WAIT_L(0); PG8_MMA(1, 0, At, B0); PG8_BAR; PG8_SCHED;
            PG8_STAGE(PG8_SB(1, 1), b3 + hstep, voffB);
            PG8_WAIT_V(6); PG8_BAR; PG8_MMA(1, 1, At, B1); PG8_BAR;
            }
        }
        if constexpr (ALIGN_EPI) { if (wr == 0) PG8_BAR; }
        if constexpr (!Epi::AFTER_DRAIN) { E(acc, cur, wr, wc, fr, fq); S.done(cur); }
        if (!has_next) break;
#pragma unroll
        for (int a = 0; a < 2; ++a)
#pragma unroll
            for (int b = 0; b < 2; ++b)
#pragma unroll
                for (int m = 0; m < 4; ++m)
#pragma unroll
                    for (int n = 0; n < 2; ++n) acc[a][b][m][n] = (f32x4){0.f, 0.f, 0.f, 0.f};
        cur = nxt; cA = nA; cB = nB; ++ui;
        if constexpr (ALIGN_EPI) { if (wr == 1) PG8_BAR; }
    }
    PG8_WAIT_V(0);
    if constexpr (!ALIGN_EPI) { if (wr == 0) PG8_BAR; }
    PG8_BAR;
    if constexpr (Epi::AFTER_DRAIN) { E.fused(acc, cur, wr, wc, fr, fq, lds, wid, lane); S.done(cur); }
#undef PG8_SA
#undef PG8_SB
#undef PG8_STAGE
#undef PG8_LDA
#undef PG8_LDB
#undef PG8_MMA
#undef PG8_WAIT_V
#undef PG8_WAIT_L
#undef PG8_BAR
#undef PG8_SCHED
}
}

#define LAS __attribute__((address_space(3)))
typedef unsigned short bf16_t;
typedef short bf16x8 __attribute__((ext_vector_type(8)));
typedef short s16x4 __attribute__((ext_vector_type(4)));
typedef short v4i16_t __attribute__((ext_vector_type(4)));
typedef float f32x4 __attribute__((ext_vector_type(4)));
typedef float f32x2 __attribute__((ext_vector_type(2)));
typedef float f32x16 __attribute__((ext_vector_type(16)));
typedef unsigned u32x4 __attribute__((ext_vector_type(4)));
typedef unsigned u32x2 __attribute__((ext_vector_type(2)));
typedef __bf16 bf16x2_t __attribute__((ext_vector_type(2)));

constexpr int NTHREADS = 512, NWAVES = 8;
constexpr int DM = 1024, NPR = 8192, MROWS = 40960, KVROWS = 45056;
constexpr size_t MiB = 1u << 20;
constexpr size_t WS_W_EIN = 0, WS_W_EOUT = 8 * MiB, WS_W_OIN = 10 * MiB, WS_W_QUP = 14 * MiB, WS_W_KVUP = 16 * MiB, WS_W_OOUT = 17 * MiB;
constexpr size_t WS_MOD = 19 * MiB, WS_TAB = 19 * MiB + 512 * 1024, WS_BAR = 19 * MiB + 768 * 1024, WS_ACT = 20 * MiB, WS_P = 100 * MiB, WS_ST = 420 * MiB, WS_END = 500 * MiB;
constexpr size_t WS_QN = WS_ACT, WS_CKV = WS_ACT + 32 * MiB, WS_KR = WS_ACT + 56 * MiB;
constexpr size_t WS_LATQ = WS_P, WS_GATE = WS_P + 120 * MiB, WS_KV = WS_P + 200 * MiB, WS_LAT16 = WS_KV, WS_X2B = WS_KV;
constexpr size_t OFF_SF = 41943040, OFF_SB = OFF_SF + 2097152, OFF_CKV = OFF_SB + 2097152, OFF_KR = OFF_CKV + 2097152, OUT_TOTAL = OFF_KR + 524288;
constexpr int LDS_BYTES = 147456;
constexpr int PP = 3072;
constexpr float EPS = 1e-6f;

struct Params { const float* in[21]; float* out; unsigned char* ws; };
enum { I_XP = 0, I_XS, I_C, I_SRF, I_SRB, I_CCKV, I_CKR, I_CCTX, I_ADAW, I_ADAB, I_NORMG, I_EINW, I_CONVW, I_EOUTW, I_OINW, I_QNG, I_KVNG, I_QUPW, I_KVUPW, I_OOUTW, I_FING };

__device__ __forceinline__ unsigned cvtpk(float lo, float hi) { f32x2 v = {lo, hi}; bf16x2_t b = __builtin_convertvector(v, bf16x2_t); return __builtin_bit_cast(unsigned, b); }
__device__ __forceinline__ bf16_t f2bf(float x) { return (bf16_t)(cvtpk(x, 0.f) & 0xffffu); }
__device__ __forceinline__ float bflo(unsigned w) { return __uint_as_float(w << 16); }
__device__ __forceinline__ float bfhi(unsigned w) { return __uint_as_float(w & 0xffff0000u); }
__device__ __forceinline__ float silu_f(float v) { return v / (1.f + __expf(-v)); }
__device__ __forceinline__ float wave_sum(float v) {
#pragma unroll
    for (int o = 1; o < 64; o <<= 1) v += __shfl_xor(v, o);
    return v;
}
__device__ __forceinline__ int crow(int r, int hi) { return (r & 3) + 8 * (r >> 2) + 4 * hi; }
__device__ __forceinline__ unsigned off_b(unsigned row, unsigned ch) { return 256u * row + 16u * (ch ^ (((row & 3) << 2) | ((row >> 2) & 3))); }
__device__ __forceinline__ s16x4 vtr(LAS const char* p) { return __builtin_bit_cast(s16x4, __builtin_amdgcn_ds_read_tr16_b64_v4i16((LAS v4i16_t*)p)); }
__device__ __forceinline__ bf16x8 mk8(s16x4 lo, s16x4 hi) { return __builtin_shufflevector(lo, hi, 0, 1, 2, 3, 4, 5, 6, 7); }
#define MFMA32(a, b, c) __builtin_amdgcn_mfma_f32_32x32x16_bf16((a), (b), (c), 0, 0, 0)

namespace pg8 {
struct EpiBf16S {
    static constexpr bool PERM = true, AFTER_DRAIN = false;
    bf16_t* O; int ldc; int s_lo, s_hi; float sc; int o2_from; bf16_t* O2; int ldc2;
    int pair_from;
    int pair_col0;
    __device__ __forceinline__ void operator()(const f32x4 (&acc)[2][2][4][2], const Unit& u, int wr, int wc, int fr, int fq) const {
        const int row0 = u.pm * BM + wr * 64 + fr;
        if (u.pn >= pair_from) {
            const bool gated = u.pn >= pair_from + 4;
            const int col0 = pair_col0 + (u.pn - pair_from) * (BM / 2) + wc * 16 + 4 * fq;
#pragma unroll
            for (int ai = 0; ai < 2; ++ai)
#pragma unroll
                for (int m = 0; m < 4; ++m) { bf16_t* rowp = O + (size_t)(row0 + ai * HALF + m * 16) * ldc + col0;
#pragma unroll
                    for (int bj = 0; bj < 2; ++bj) { const f32x4 a0 = acc[ai][bj][m][0]; f32x4 a1 = acc[ai][bj][m][1];
                        if (gated) { a1[0] = a1[0] / (1.f + __expf(-a1[0])); a1[1] = a1[1] / (1.f + __expf(-a1[1])); a1[2] = a1[2] / (1.f + __expf(-a1[2])); a1[3] = a1[3] / (1.f + __expf(-a1[3])); }
                        const f32x4 v = a0 * a1; u32x2 w; w.x = ::cvtpk(v[0], v[1]); w.y = ::cvtpk(v[2], v[3]);
                        __builtin_nontemporal_store(w, (u32x2*)(rowp + bj * (HALF / 2))); } }
            return;
        }
        const bool second = u.pn >= o2_from;
        bf16_t* base = second ? O2 : O; const int ld = second ? ldc2 : ldc;
        const float s = (u.pn >= s_lo && u.pn < s_hi) ? sc : 1.f;
        const int col0 = (second ? u.pn - o2_from : u.pn) * BM + wc * 32 + 8 * fq;
#pragma unroll
        for (int ai = 0; ai < 2; ++ai)
#pragma unroll
            for (int m = 0; m < 4; ++m) { bf16_t* rowp = base + (size_t)(row0 + ai * HALF + m * 16) * ld + col0;
#pragma unroll
                for (int bj = 0; bj < 2; ++bj) { const f32x4 v0 = acc[ai][bj][m][0] * s, v1 = acc[ai][bj][m][1] * s;
                    u32x4 w; w.x = ::cvtpk(v0[0], v0[1]); w.y = ::cvtpk(v0[2], v0[3]); w.z = ::cvtpk(v1[0], v1[1]); w.w = ::cvtpk(v1[2], v1[3]);
                    __builtin_nontemporal_store(w, (u32x4*)(rowp + bj * HALF)); } }
    }
};
struct EpiRes {
    static constexpr bool PERM = false, AFTER_DRAIN = false;
    const float* xp; const float* xs; const bf16_t* B16; bf16_t* O16; const float* modl; int pm0;
    __device__ __forceinline__ void operator()(const f32x4 (&acc)[2][2][4][2], const Unit& u, int wr, int wc, int fr, int fq) const {
        const int pma = u.pm + pm0; const int r = pma < 32 ? 8 : ((pma - 32) >> 4);
        const float* gate = modl + r * 3072 + 2048;
        const int col0 = u.pn * BM + wc * 32 + 4 * fq;
        f32x4 gv[2][2];
#pragma unroll
        for (int bj = 0; bj < 2; ++bj)
#pragma unroll
            for (int n = 0; n < 2; ++n) gv[bj][n] = *(const f32x4*)(gate + col0 + bj * HALF + n * 16);
#pragma unroll
        for (int ai = 0; ai < 2; ++ai)
#pragma unroll
            for (int m = 0; m < 4; ++m) { const int row = pma * BM + ai * HALF + wr * 64 + m * 16 + fr;
                const float* xr = (row < 8192) ? xp + (size_t)row * 1024 : xs + (size_t)(row - 8192) * 1024;
#pragma unroll
                for (int bj = 0; bj < 2; ++bj)
#pragma unroll
                    for (int n = 0; n < 2; ++n) { const int c = col0 + bj * HALF + n * 16; f32x4 xv;
                        if (B16) { const u32x2 w = *(const u32x2*)(B16 + (size_t)row * 1024 + c); xv = (f32x4){::bflo(w.x), ::bfhi(w.x), ::bflo(w.y), ::bfhi(w.y)}; }
                        else xv = __builtin_nontemporal_load((const f32x4*)(xr + c));
                        const f32x4 o = xv + gv[bj][n] * acc[ai][bj][m][n];
                        u32x2 w2; w2.x = ::cvtpk(o[0], o[1]); w2.y = ::cvtpk(o[2], o[3]); *(u32x2*)(O16 + (size_t)row * 1024 + c) = w2; } }
    }
};
struct EpiQ {
    static constexpr bool PERM = false, AFTER_DRAIN = false;
    bf16_t* O; const f32x2* tab;
    __device__ __forceinline__ void operator()(const f32x4 (&acc)[2][2][4][2], const Unit& u, int wr, int wc, int fr, int fq) const {
        const bool rope = u.pm >= 32;
        const int col0 = u.pn * BM + wc * 32 + 4 * fq;
#pragma unroll
        for (int ai = 0; ai < 2; ++ai)
#pragma unroll
            for (int m = 0; m < 4; ++m) { const int row = u.pm * BM + ai * HALF + wr * 64 + m * 16 + fr; const int t = (row - 8192) & 4095;
                bf16_t* rowp = O + (size_t)row * 1536 + col0;
#pragma unroll
                for (int bj = 0; bj < 2; ++bj) { f32x4 v0 = acc[ai][bj][m][0], v1 = acc[ai][bj][m][1];
                    const int g = 8 * u.pn + 4 * bj + wc, gh = g % 6;
                    if (rope && gh >= 4) { const int pos = (gh == 4) ? (t >> 6) : (t & 63); const f32x2* tp = tab + pos * 16 + 4 * fq;
#pragma unroll
                        for (int e = 0; e < 4; ++e) { const f32x2 cs = tp[e]; const float x1 = v0[e], x2 = v1[e]; v0[e] = x1 * cs.x - x2 * cs.y; v1[e] = x1 * cs.y + x2 * cs.x; } }
                    u32x2 w0, w1; w0.x = ::cvtpk(v0[0], v0[1]); w0.y = ::cvtpk(v0[2], v0[3]); w1.x = ::cvtpk(v1[0], v1[1]); w1.y = ::cvtpk(v1[2], v1[3]);
                    *(u32x2*)(rowp + bj * HALF) = w0; *(u32x2*)(rowp + bj * HALF + 16) = w1; }
                asm volatile("" ::: "memory"); }
    }
};
}

__device__ __forceinline__ int ein_row(int n) {
    if (n < 2048) return n;
    const int sec = (n - 2048) >> 9, ch = (n - 2048) & 511, g8 = 8 * (ch >> 2) + (ch & 3);
    return sec == 0 ? 3072 + g8 : sec == 1 ? 2048 + g8 : sec == 2 ? 2048 + g8 + 4 : 3072 + g8 + 4;
}
__device__ __forceinline__ void transpose_item(const float* __restrict__ W, int K, int N, bf16_t* WT, int k0, int n0, int drow0, LAS float* scr, int lane, int kind = 0) {
#pragma unroll 8
    for (int i = 0; i < 32; ++i) { const int kk = 2 * i + (lane >> 5); scr[kk * 33 + (lane & 31)] = __builtin_nontemporal_load(W + (size_t)(k0 + kk) * N + n0 + (lane & 31)); }
    asm volatile("s_waitcnt lgkmcnt(0)" ::: "memory");
    const int c = lane & 7;
#pragma unroll
    for (int j = 0; j < 4; ++j) { const int n = (lane >> 3) + 8 * j; const LAS float* s = scr + (8 * c) * 33 + n;
        u32x4 o; o.x = cvtpk(s[0 * 33], s[1 * 33]); o.y = cvtpk(s[2 * 33], s[3 * 33]); o.z = cvtpk(s[4 * 33], s[5 * 33]); o.w = cvtpk(s[6 * 33], s[7 * 33]);
        *(u32x4*)(WT + (size_t)(kind ? ein_row(n0 + n) : drow0 + n) * K + k0 + 8 * c) = o; }
    asm volatile("s_waitcnt lgkmcnt(0)" ::: "memory");
}

__device__ __forceinline__ void p0_phase(const Params& p, LAS char* L, int G) {
    const int tid = threadIdx.x, lane = tid & 63, wave = tid >> 6;
    unsigned char* ws = p.ws;
    float* mod = (float*)(ws + WS_MOD);
    if ((int)blockIdx.x < 192) {
        LAS float* sil = (LAS float*)L; LAS float* red = (LAS float*)(L + 36864);
        for (int i = tid; i < 9216; i += NTHREADS) { const int r = i >> 10, k = i & 1023; const float v = r < 8 ? p.in[I_C][r * 1024 + k] : p.in[I_CCTX][k]; sil[i] = v / (1.f + expf(-v)); }
        __syncthreads();
        for (int it = blockIdx.x; it < 192; it += G) {
            const int l = it / 96, n0 = (it % 96) * 32, col = lane & 31, ksub = lane >> 5;
            const float* Wl = p.in[I_ADAW] + (size_t)l * 1024 * 3072 + n0 + col;
            float a[9];
#pragma unroll
            for (int r = 0; r < 9; ++r) a[r] = 0.f;
#pragma unroll 8
            for (int i = 0; i < 64; ++i) { const int k = 128 * wave + 2 * i + ksub; const float w = __builtin_nontemporal_load(Wl + (size_t)k * 3072);
#pragma unroll
                for (int r = 0; r < 9; ++r) a[r] += sil[r * 1024 + k] * w; }
#pragma unroll
            for (int r = 0; r < 9; ++r) { a[r] += __shfl_xor(a[r], 32); if (ksub == 0) red[(wave * 9 + r) * 32 + col] = a[r]; }
            __syncthreads();
            if (tid < 288) { const int r = tid >> 5, cc = tid & 31; float s = p.in[I_ADAB][l * 3072 + n0 + cc];
#pragma unroll
                for (int w = 0; w < 8; ++w) s += red[(w * 9 + r) * 32 + cc];
                mod[(size_t)(l * 9 + r) * 3072 + n0 + cc] = s; }
            __syncthreads();
        }
    }
    { const int gt = blockIdx.x * NTHREADS + tid;
      if (gt < 1024) { const int pos = gt >> 4, fi = gt & 15; const float inv = exp2f(-(float)fi * (13.287712379549449f / 16.f)); const float ang = (float)pos * inv;
          float rev = ang * 0.15915494309189535f; rev -= floorf(rev);
          ((f32x2*)(ws + WS_TAB))[gt] = (f32x2){__builtin_amdgcn_cosf(rev), __builtin_amdgcn_sinf(rev)}; } }
    { const int gt = blockIdx.x * NTHREADS + tid; u32x4* z = (u32x4*)(ws + WS_W_OIN + (size_t)1728 * 1024 * 2);
      for (int i = gt; i < 64 * 1024 * 2 / 16; i += G * NTHREADS) z[i] = (u32x4){0u, 0u, 0u, 0u}; }
    LAS float* scr = (LAS float*)(L + 49152 + wave * 8448);
    const int gw = blockIdx.x * NWAVES + wave, NGW = G * NWAVES;
    constexpr int I0 = 16 * 128, I1 = 16 * 32, I2 = 16 * 54, I3 = 6 * 48, I4 = 4 * 64, I5 = 16 * 32, NIT = I0 + I1 + I2 + I3 + I4 + I5;
    for (int it = gw; it < NIT; it += NGW) {
        int r = it;
        if (r < I0) { const int nb = r % 128, kb = r / 128; transpose_item(p.in[I_EINW], 1024, 4096, (bf16_t*)(ws + WS_W_EIN), kb * 64, nb * 32, nb * 32, scr, lane, 1); continue; } r -= I0;
        if (r < I1) { const int nb = r % 32, kb = r / 32; transpose_item(p.in[I_EOUTW], 1024, 1024, (bf16_t*)(ws + WS_W_EOUT), kb * 64, nb * 32, nb * 32, scr, lane); continue; } r -= I1;
        if (r < I2) { const int nb = r % 54, kb = r / 54, n0 = nb * 32; const int d0 = n0 < 704 ? n0 + 1024 : n0 - 704;
            transpose_item(p.in[I_OINW], 1024, 1728, (bf16_t*)(ws + WS_W_OIN), kb * 64, n0, d0, scr, lane); continue; } r -= I2;
        if (r < I3) { const int nb = r % 48, kb = r / 48; transpose_item(p.in[I_QUPW], 384, 1536, (bf16_t*)(ws + WS_W_QUP), kb * 64, nb * 32, nb * 32, scr, lane); continue; } r -= I3;
        if (r < I4) { const int nb = r % 64, kb = r / 64; transpose_item(p.in[I_KVUPW], 256, 2048, (bf16_t*)(ws + WS_W_KVUP), kb * 64, nb * 32, nb * 32, scr, lane); continue; } r -= I4;
        { const int nb = r % 32, kb = r / 32; transpose_item(p.in[I_OOUTW], 1024, 1024, (bf16_t*)(ws + WS_W_OOUT), kb * 64, nb * 32, nb * 32, scr, lane); }
    }
}

__device__ __forceinline__ f32x4 ld_row4(const float* xf, const bf16_t* x16, size_t off) {
    if (x16) { const u32x2 w = *(const u32x2*)(x16 + off); return (f32x4){bflo(w.x), bfhi(w.x), bflo(w.y), bfhi(w.y)}; }
    return __builtin_nontemporal_load((const f32x4*)(xf + off));
}
__device__ __forceinline__ void norm_mod_phase(const float* xp, const float* xs, const bf16_t* x16, const float* g, const float* modl, bf16_t* H, int gwb, int nwb, int lo0, int hi0, int lo1, int hi1) {
    const int lane = threadIdx.x & 63, wave = threadIdx.x >> 6;
    const int gw = gwb * NWAVES + wave, NGW = nwb * NWAVES, n0_ = hi0 - lo0, total = n0_ + (hi1 - lo1);
    f32x4 gv[4];
#pragma unroll
    for (int j = 0; j < 4; ++j) gv[j] = *(const f32x4*)(g + 4 * lane + 256 * j);
    for (int i0 = gw; i0 < total; i0 += 2 * NGW) {
        const bool has1 = i0 + NGW < total; const int i1 = has1 ? i0 + NGW : i0;
        const int m0 = i0 < n0_ ? lo0 + i0 : lo1 + (i0 - n0_), m1 = i1 < n0_ ? lo0 + i1 : lo1 + (i1 - n0_);
        const float* xf0 = x16 ? nullptr : ((m0 < NPR) ? xp + (size_t)m0 * DM : xs + (size_t)(m0 - NPR) * DM);
        const float* xf1 = x16 ? nullptr : ((m1 < NPR) ? xp + (size_t)m1 * DM : xs + (size_t)(m1 - NPR) * DM);
        const bf16_t* xb0 = x16 ? x16 + (size_t)m0 * DM : nullptr; const bf16_t* xb1 = x16 ? x16 + (size_t)m1 * DM : nullptr;
        const float* md0 = modl + ((m0 < NPR) ? 8 : ((m0 - NPR) >> 12)) * 3072; const float* md1 = modl + ((m1 < NPR) ? 8 : ((m1 - NPR) >> 12)) * 3072;
        f32x4 v0[4], v1[4], sc0[4], sh0[4], sc1[4], sh1[4];
#pragma unroll
        for (int j = 0; j < 4; ++j) { const int c = 4 * lane + 256 * j; v0[j] = ld_row4(xf0, xb0, c); v1[j] = ld_row4(xf1, xb1, c); }
#pragma unroll
        for (int j = 0; j < 4; ++j) { const int c = 4 * lane + 256 * j; sh0[j] = *(const f32x4*)(md0 + c); sc0[j] = *(const f32x4*)(md0 + 1024 + c); sh1[j] = *(const f32x4*)(md1 + c); sc1[j] = *(const f32x4*)(md1 + 1024 + c); }
        float s0 = 0.f, s1 = 0.f;
#pragma unroll
        for (int j = 0; j < 4; ++j) { s0 += (v0[j].x * v0[j].x + v0[j].y * v0[j].y) + (v0[j].z * v0[j].z + v0[j].w * v0[j].w); s1 += (v1[j].x * v1[j].x + v1[j].y * v1[j].y) + (v1[j].z * v1[j].z + v1[j].w * v1[j].w); }
#pragma unroll
        for (int o = 1; o < 64; o <<= 1) { s0 += __shfl_xor(s0, o); s1 += __shfl_xor(s1, o); }
        const float r0 = rsqrtf(s0 * (1.f / DM) + EPS), r1 = rsqrtf(s1 * (1.f / DM) + EPS);
#pragma unroll
        for (int j = 0; j < 4; ++j) { const int c = 4 * lane + 256 * j;
            { const f32x4 h = (v0[j] * r0) * gv[j] * (sc0[j] + 1.f) + sh0[j]; u32x2 w; w.x = cvtpk(h.x, h.y); w.y = cvtpk(h.z, h.w); *(u32x2*)(H + (size_t)m0 * DM + c) = w; }
            if (has1) { const f32x4 h = (v1[j] * r1) * gv[j] * (sc1[j] + 1.f) + sh1[j]; u32x2 w; w.x = cvtpk(h.x, h.y); w.y = cvtpk(h.z, h.w); *(u32x2*)(H + (size_t)m1 * DM + c) = w; } }
    }
}

__device__ __forceinline__ void ret_local_phase(const Params& p, LAS char* L, int G) {
    const int tid = threadIdx.x, lane = tid & 63, wave = tid >> 6, h5 = lane >> 5, l31 = lane & 31, dir = wave >> 2, eb = wave & 3;
    const int blk = (lane >> 4) & 1, q = (lane & 15) >> 2, pp = lane & 3;
    const bf16_t* P = (const bf16_t*)(p.ws + WS_P); bf16_t* ST = (bf16_t*)(p.ws + WS_ST);
    LAS char* Vt = L; LAS char* Kt = L + 32768 + dir * 32768;
    const unsigned r0 = 8 * h5 + q, r1 = r0 + 4;
    const unsigned aA0 = off_b(r0, 4 * eb + 2 * blk + (pp >> 1)) + 8 * (pp & 1), aA1 = off_b(r1, 4 * eb + 2 * blk + (pp >> 1)) + 8 * (pp & 1);
    const int njobs = 1024 + 256;
    for (int u = blockIdx.x; u < 1024 + 128; u += G) {
        const bool ctx = u >= 1024; const int v_ = u & 255; const int hh = ctx ? (u & 3) : ((v_ >> 3) & 3);
        const float lgf = log2f(1.f - exp2f(-5.f - (float)hh)), lgb = log2f(1.f - exp2f(-5.5f - (float)hh));
        const float cdec = exp2f(128.f * (dir ? lgb : lgf));
        const int seq = (u - 1024) >> 2;
#pragma unroll 1
        for (int j = 0; j < (ctx ? 2 : 1); ++j) {
            const int gc = ctx ? 2 * seq + j : 64 + (u >> 8) * 64 + (v_ & 7) + 8 * (v_ >> 5);
            const size_t rowbase = (size_t)gc * 128;
            __syncthreads();
#pragma unroll
            for (int i = 0; i < 4; ++i) { const int n = tid + 512 * i, row = n >> 4, ch = n & 15; const bf16_t* gp = P + (rowbase + row) * PP + hh * 128 + ch * 8;
                const u32x4 w = *(const u32x4*)(gp + 512), v = *(const u32x4*)(gp + 1024); const unsigned o = off_b(row, ch);
                const float kf = exp2f(lgf * (float)(127 - row)), kb = exp2f(lgb * (float)row);
                u32x4 a, b;
                a.x = cvtpk(bflo(w.x) * kf, bfhi(w.x) * kf); a.y = cvtpk(bflo(w.y) * kf, bfhi(w.y) * kf); a.z = cvtpk(bflo(w.z) * kf, bfhi(w.z) * kf); a.w = cvtpk(bflo(w.w) * kf, bfhi(w.w) * kf);
                b.x = cvtpk(bflo(w.x) * kb, bfhi(w.x) * kb); b.y = cvtpk(bflo(w.y) * kb, bfhi(w.y) * kb); b.z = cvtpk(bflo(w.z) * kb, bfhi(w.z) * kb); b.w = cvtpk(bflo(w.w) * kb, bfhi(w.w) * kb);
                *(LAS u32x4*)(Vt + o) = v; *(LAS u32x4*)(L + 32768 + o) = a; *(LAS u32x4*)(L + 65536 + o) = b; }
            __syncthreads();
            f32x16 acc[4];
#pragma unroll
            for (int x = 0; x < 4; ++x)
#pragma unroll
                for (int r = 0; r < 16; ++r) acc[x][r] = 0.f;
#pragma unroll 2
            for (int ks = 0; ks < 8; ++ks) {
                const bf16x8 A = mk8(vtr(Vt + aA0 + 4096 * ks), vtr(Vt + aA1 + 4096 * ks));
#pragma unroll
                for (int x = 0; x < 4; ++x) { const unsigned cb = 4 * x + 2 * blk + (pp >> 1);
                    const bf16x8 B = mk8(vtr(Kt + off_b(r0, cb) + 8 * (pp & 1) + 4096 * ks), vtr(Kt + off_b(r1, cb) + 8 * (pp & 1) + 4096 * ks));
                    acc[x] = MFMA32(A, B, acc[x]); }
            }
            bf16_t* own = ST + ((size_t)(gc * 4 + hh) * 2 + dir) * 16384;
            if (!ctx) {
#pragma unroll
                for (int x = 0; x < 4; ++x)
#pragma unroll
                    for (int r = 0; r < 16; ++r) own[(32 * eb + crow(r, h5)) * 128 + 32 * x + l31] = f2bf(acc[x][r]);
            } else {
                const bool first_in_dir = (dir == 0) ? (j == 0) : (j == 1);
                bf16_t* other = ST + ((size_t)((gc ^ 1) * 4 + hh) * 2 + dir) * 16384;
                if (first_in_dir) {
#pragma unroll
                    for (int x = 0; x < 4; ++x)
#pragma unroll
                        for (int r = 0; r < 16; ++r) { const int o = (32 * eb + crow(r, h5)) * 128 + 32 * x + l31; own[o] = 0; other[o] = f2bf(acc[x][r]); }
                }
                float* dst = p.out + (dir ? OFF_SB : OFF_SF) + (size_t)(seq * 4 + hh) * 16384;
                const float sc = first_in_dir ? cdec : 1.f;
#pragma unroll
                for (int x = 0; x < 4; ++x) { const int d = 32 * x + l31;
#pragma unroll
                    for (int rg = 0; rg < 4; ++rg) { float* dp = dst + d * 128 + 32 * eb + 8 * rg + 4 * h5;
                        f32x4 v = (f32x4){acc[x][4 * rg], acc[x][4 * rg + 1], acc[x][4 * rg + 2], acc[x][4 * rg + 3]} * sc;
                        if (j == 1) v += *(const f32x4*)dp;
                        *(f32x4*)dp = v; } }
            }
        }
    }
}
__device__ __forceinline__ void ret_scan2_phase(const Params& p, int G) {
    bf16_t* ST = (bf16_t*)(p.ws + WS_ST);
    for (int it = blockIdx.x * NTHREADS + threadIdx.x; it < 64 * 2048; it += G * NTHREADS) {
        const int chain = it >> 11, b = chain >> 3, hh = (chain >> 1) & 3, dir = chain & 1, e = (it >> 4) & 127, d0 = (it & 15) * 8;
        const float lg = log2f(1.f - exp2f(-5.f - (float)hh - 0.5f * (float)dir)), cdec = exp2f(128.f * lg);
        const float* src = p.in[dir ? I_SRB : I_SRF] + (size_t)(b * 4 + hh) * 16384;
        float S[8];
#pragma unroll
        for (int i = 0; i < 8; ++i) S[i] = src[(d0 + i) * 128 + e];
        bf16_t* base = ST + ((size_t)((64 + b * 32) * 4 + hh) * 2 + dir) * 16384 + e * 128 + d0;
#pragma unroll 1
        for (int kb = 0; kb < 2; ++kb) {
            u32x4 Lr[16];
#pragma unroll
            for (int i = 0; i < 16; ++i) { const int c = dir ? 31 - (kb * 16 + i) : kb * 16 + i; Lr[i] = *(const u32x4*)(base + (size_t)c * 8 * 16384); }
#pragma unroll
            for (int i = 0; i < 16; ++i) { const int c = dir ? 31 - (kb * 16 + i) : kb * 16 + i;
                u32x4 o; o.x = cvtpk(S[0], S[1]); o.y = cvtpk(S[2], S[3]); o.z = cvtpk(S[4], S[5]); o.w = cvtpk(S[6], S[7]);
                *(u32x4*)(base + (size_t)c * 8 * 16384) = o;
                const u32x4 w = Lr[i];
                S[0] = S[0] * cdec + bflo(w.x); S[1] = S[1] * cdec + bfhi(w.x); S[2] = S[2] * cdec + bflo(w.y); S[3] = S[3] * cdec + bfhi(w.y);
                S[4] = S[4] * cdec + bflo(w.z); S[5] = S[5] * cdec + bfhi(w.z); S[6] = S[6] * cdec + bflo(w.w); S[7] = S[7] * cdec + bfhi(w.w); }
        }
    }
}

__device__ __forceinline__ void ret_out_phase(const Params& p, LAS char* L, int G) {
    const int tid = threadIdx.x, lane = tid & 63, wave = tid >> 6, h5 = lane >> 5, blk = (lane >> 4) & 1, q = (lane & 15) >> 2, pp = lane & 3, l31 = lane & 31;
    LAS char* Qt = L; LAS char* Kt = L + 32768; LAS char* Vt = L + 65536; LAS float* ssq = (LAS float*)(L + 98304);
    const bf16_t* P = (const bf16_t*)(p.ws + WS_P); const bf16_t* ST = (const bf16_t*)(p.ws + WS_ST); bf16_t* MIX = (bf16_t*)(p.ws + WS_ACT);
    const float* convw = p.in[I_CONVW];
    const int ib = wave & 3, eh = wave >> 2;
    for (int u = blockIdx.x; u < 1280; u += G) {
        const int v_ = u & 255, hh = (v_ >> 3) & 3, gc = (u >> 8) * 64 + (v_ & 7) + 8 * (v_ >> 5);
        const size_t rowbase = (size_t)gc * 128;
        const int T = gc < 64 ? 256 : 4096, tok0 = gc < 64 ? (gc & 1) * 128 : ((gc - 64) & 31) * 128;
        const float lgf = log2f(1.f - exp2f(-5.f - (float)hh)), lgb = log2f(1.f - exp2f(-5.5f - (float)hh));
        const int i_tok = 32 * ib + l31;
        const bf16_t* stf = ST + ((size_t)gc * 4 + hh) * 2 * 16384; const bf16_t* stb = stf + 16384;
        u32x4 tq[4], tf[4], tb[4], tk[4], tv[4], tg[4];
#pragma unroll
        for (int i = 0; i < 4; ++i) { const int n = tid + 512 * i, row = n >> 4, ch = n & 15; const bf16_t* gp = P + (rowbase + row) * PP + hh * 128 + ch * 8;
            tq[i] = *(const u32x4*)gp; tf[i] = *(const u32x4*)(stf + row * 128 + ch * 8); tb[i] = *(const u32x4*)(stb + row * 128 + ch * 8); }
#pragma unroll
        for (int i = 0; i < 4; ++i) { const int n = tid + 512 * i, row = n >> 4, ch = n & 15; const bf16_t* gp = P + (rowbase + row) * PP + hh * 128 + ch * 8;
            tk[i] = *(const u32x4*)(gp + 512); tv[i] = *(const u32x4*)(gp + 1024); tg[i] = *(const u32x4*)(gp + 1536); }
        __syncthreads();
#pragma unroll
        for (int i = 0; i < 4; ++i) { const int n = tid + 512 * i, row = n >> 4, ch = n & 15; const unsigned o = off_b(row, ch);
            *(LAS u32x4*)(Qt + o) = tq[i]; *(LAS u32x4*)(Kt + o) = tf[i]; *(LAS u32x4*)(Vt + o) = tb[i]; }
        __syncthreads();
        f32x16 o[2];
        {
            f32x16 aF[2], aB[2];
#pragma unroll
            for (int x = 0; x < 2; ++x)
#pragma unroll
                for (int r = 0; r < 16; ++r) { aF[x][r] = 0.f; aB[x][r] = 0.f; }
#pragma unroll
            for (int s = 0; s < 8; ++s) {
                const bf16x8 qf = *(const LAS bf16x8*)(Qt + off_b(i_tok, 2 * s + h5));
#pragma unroll
                for (int x = 0; x < 2; ++x) { const unsigned er = 32 * (2 * eh + x) + l31;
                    const bf16x8 af = *(const LAS bf16x8*)(Kt + off_b(er, 2 * s + h5)), ab = *(const LAS bf16x8*)(Vt + off_b(er, 2 * s + h5));
                    aF[x] = MFMA32(af, qf, aF[x]); aB[x] = MFMA32(ab, qf, aB[x]); }
            }
            const float qdf = exp2f(lgf * (float)(i_tok + 1)), qdb = exp2f(lgb * (float)(128 - i_tok));
#pragma unroll
            for (int x = 0; x < 2; ++x)
#pragma unroll
                for (int r = 0; r < 16; ++r) o[x][r] = qdf * aF[x][r] + qdb * aB[x][r];
        }
        __syncthreads();
#pragma unroll
        for (int i = 0; i < 4; ++i) { const int n = tid + 512 * i, row = n >> 4, ch = n & 15; const unsigned oo = off_b(row, ch);
            *(LAS u32x4*)(Kt + oo) = tk[i]; *(LAS u32x4*)(Vt + oo) = tv[i]; }
        __syncthreads();
#pragma unroll 1
        for (int jb = 0; jb < 4; ++jb) {
            f32x16 pacc;
#pragma unroll
            for (int r = 0; r < 16; ++r) pacc[r] = 0.f;
#pragma unroll
            for (int s = 0; s < 8; ++s) {
                const bf16x8 kf = *(const LAS bf16x8*)(Kt + off_b(32 * jb + l31, 2 * s + h5));
                const bf16x8 qf = *(const LAS bf16x8*)(Qt + off_b(i_tok, 2 * s + h5));
                pacc = MFMA32(kf, qf, pacc);
            }
#pragma unroll
            for (int r = 0; r < 16; ++r) { const int j = 32 * jb + crow(r, h5); const int dij = i_tok - j;
                const float mval = dij > 0 ? exp2f(lgf * (float)dij) : (dij < 0 ? exp2f(lgb * (float)(-dij)) : 2.f);
                pacc[r] *= mval; }
#pragma unroll
            for (int s2 = 0; s2 < 2; ++s2) {
                u32x4 w; w.x = cvtpk(pacc[8 * s2], pacc[8 * s2 + 1]); w.y = cvtpk(pacc[8 * s2 + 2], pacc[8 * s2 + 3]); w.z = cvtpk(pacc[8 * s2 + 4], pacc[8 * s2 + 5]); w.w = cvtpk(pacc[8 * s2 + 6], pacc[8 * s2 + 7]);
                const bf16x8 xs = __builtin_bit_cast(bf16x8, w);
                const unsigned r0 = 32 * jb + 16 * s2 + 4 * h5 + q, r1 = r0 + 8;
#pragma unroll
                for (int x = 0; x < 2; ++x) { const unsigned cb = 4 * (2 * eh + x) + 2 * blk + (pp >> 1);
                    const bf16x8 vf = mk8(vtr(Vt + off_b(r0, cb) + 8 * (pp & 1)), vtr(Vt + off_b(r1, cb) + 8 * (pp & 1)));
                    o[x] = MFMA32(vf, xs, o[x]); }
            }
        }
        float ss = 0.f;
#pragma unroll
        for (int x = 0; x < 2; ++x)
#pragma unroll
            for (int r = 0; r < 16; ++r) ss += o[x][r] * o[x][r];
        ss += __shfl_xor(ss, 32);
        if (h5 == 0) ssq[wave * 32 + l31] = ss;
        __syncthreads();
        ss += ssq[(wave ^ 4) * 32 + l31];
        const float rstd = rsqrtf(ss * (1.f / 128.f) + EPS);
#pragma unroll
        for (int x = 0; x < 2; ++x)
#pragma unroll
            for (int rg = 0; rg < 4; ++rg) { const int e0 = 32 * (2 * eh + x) + 8 * rg + 4 * h5;
                u32x2 w; w.x = cvtpk(o[x][4 * rg] * rstd, o[x][4 * rg + 1] * rstd); w.y = cvtpk(o[x][4 * rg + 2] * rstd, o[x][4 * rg + 3] * rstd);
                *(LAS u32x2*)(Qt + off_b(i_tok, e0 >> 3) + 2 * (e0 & 7)) = w; }
        __syncthreads();
#pragma unroll
        for (int i = 0; i < 4; ++i) { const int n = tid + 512 * i, row = n >> 4, ch = n & 15;
            const u32x4 ov = *(const LAS u32x4*)(Qt + off_b(row, ch)); const u32x4 g = tg[i]; u32x4 w;
            w.x = cvtpk(bflo(ov.x) * silu_f(bflo(g.x)), bfhi(ov.x) * silu_f(bfhi(g.x))); w.y = cvtpk(bflo(ov.y) * silu_f(bflo(g.y)), bfhi(ov.y) * silu_f(bfhi(g.y)));
            w.z = cvtpk(bflo(ov.z) * silu_f(bflo(g.z)), bfhi(ov.z) * silu_f(bfhi(g.z))); w.w = cvtpk(bflo(ov.w) * silu_f(bflo(g.w)), bfhi(ov.w) * silu_f(bfhi(g.w)));
            *(u32x4*)(MIX + (rowbase + row) * 1024 + hh * 128 + ch * 8) = w; }
        { const int c8 = (tid & 15) * 8, tr = tid >> 4, cc = hh * 128 + c8;
          float w0[8], w1[8], w2[8];
#pragma unroll
          for (int e_ = 0; e_ < 8; ++e_) { w0[e_] = convw[cc + e_]; w1[e_] = convw[512 + cc + e_]; w2[e_] = convw[1024 + cc + e_]; }
#pragma unroll 2
          for (int itk = 0; itk < 4; ++itk) { const int tk_ = itk * 32 + tr, pos = tok0 + tk_; const bf16_t* rp = P + (rowbase + tk_) * PP + cc;
              const u32x4 zero4 = (u32x4){0u, 0u, 0u, 0u};
              const u32x4 gb = *(const u32x4*)(rp + 2560), z1 = *(const u32x4*)(rp + 2048);
              const u32x4 z0 = pos > 0 ? *(const u32x4*)(rp - PP + 2048) : zero4, z2 = pos + 1 < T ? *(const u32x4*)(rp + PP + 2048) : zero4;
              float y[8];
#pragma unroll
              for (int e2 = 0; e2 < 4; ++e2) {
                  y[2 * e2] = bflo(gb[e2]) * (bflo(z0[e2]) * w0[2 * e2] + bflo(z1[e2]) * w1[2 * e2] + bflo(z2[e2]) * w2[2 * e2]);
                  y[2 * e2 + 1] = bfhi(gb[e2]) * (bfhi(z0[e2]) * w0[2 * e2 + 1] + bfhi(z1[e2]) * w1[2 * e2 + 1] + bfhi(z2[e2]) * w2[2 * e2 + 1]); }
              u32x4 w; w.x = cvtpk(y[0], y[1]); w.y = cvtpk(y[2], y[3]); w.z = cvtpk(y[4], y[5]); w.w = cvtpk(y[6], y[7]);
              *(u32x4*)(MIX + (rowbase + tk_) * 1024 + 512 + cc) = w; } }
    }
}

__device__ __forceinline__ void lat_phase(const Params& p, int G) {
    const int lane = threadIdx.x & 63, wave = threadIdx.x >> 6;
    const int gw = blockIdx.x * NWAVES + wave, NGW = G * NWAVES;
    const bf16_t* LAT = (const bf16_t*)(p.ws + WS_LAT16); bf16_t* QN = (bf16_t*)(p.ws + WS_QN); bf16_t* CKV = (bf16_t*)(p.ws + WS_CKV); bf16_t* KR = (bf16_t*)(p.ws + WS_KR);
    const f32x2* tab = (const f32x2*)(p.ws + WS_TAB);
    const float* qng = p.in[I_QNG]; const float* kvng = p.in[I_KVNG];
    for (int m = gw; m < KVROWS; m += NGW) {
        if (m < MROWS) {
            const bf16_t* lat = LAT + (size_t)m * 768;
            unsigned qw[3];
#pragma unroll
            for (int j = 0; j < 3; ++j) qw[j] = *(const unsigned*)(lat + 2 * lane + 128 * j);
            const u32x2 kw = *(const u32x2*)(lat + 384 + 4 * lane);
            const float kr = __uint_as_float((unsigned)lat[640 + lane] << 16);
            f32x2 qv[3]; float ssq = 0.f;
#pragma unroll
            for (int j = 0; j < 3; ++j) { qv[j] = (f32x2){bflo(qw[j]), bfhi(qw[j])}; ssq += qv[j].x * qv[j].x + qv[j].y * qv[j].y; }
            const f32x4 kv = (f32x4){bflo(kw.x), bfhi(kw.x), bflo(kw.y), bfhi(kw.y)};
            float ssk = (kv.x * kv.x + kv.y * kv.y) + (kv.z * kv.z + kv.w * kv.w);
#pragma unroll
            for (int o = 1; o < 64; o <<= 1) { ssq += __shfl_xor(ssq, o); ssk += __shfl_xor(ssk, o); }
            { const float rstd = rsqrtf(ssq * (1.f / 384.f) + EPS);
#pragma unroll
              for (int j = 0; j < 3; ++j) { const f32x2 gv = *(const f32x2*)(qng + 2 * lane + 128 * j); *(unsigned*)(QN + (size_t)m * 384 + 2 * lane + 128 * j) = cvtpk(qv[j].x * rstd * gv.x, qv[j].y * rstd * gv.y); } }
            const bool prompt = m < NPR; const int ms = m - NPR;
            const size_t kvrow = prompt ? (size_t)m : (size_t)NPR + (size_t)(ms >> 12) * 4608 + 512 + (ms & 4095);
            { const float rstd = rsqrtf(ssk * (1.f / 256.f) + EPS); const f32x4 gv = *(const f32x4*)(kvng + 4 * lane); const f32x4 ck = kv * rstd * gv;
              if (prompt) *(f32x4*)(p.out + OFF_CKV + (size_t)m * 256 + 4 * lane) = ck;
              u32x2 w; w.x = cvtpk(ck.x, ck.y); w.y = cvtpk(ck.z, ck.w); *(u32x2*)(CKV + kvrow * 256 + 4 * lane) = w; }
            { float outv = kr;
              if (prompt) p.out[OFF_KR + (size_t)m * 64 + lane] = kr;
              const float other = __shfl_xor(kr, 16);
              if (!prompt) { const int t = ms & 4095, half = lane >> 5, idx = lane & 31, fi = idx & 15, hi2 = idx >> 4; const int pos = half ? (t & 63) : (t >> 6);
                  const f32x2 cs = tab[pos * 16 + fi]; const float x1 = hi2 ? other : kr, x2 = hi2 ? kr : other; outv = hi2 ? (x1 * cs.y + x2 * cs.x) : (x1 * cs.x - x2 * cs.y); }
              KR[kvrow * 64 + lane] = f2bf(outv); }
        } else {
            const int cm = m - MROWS, b = cm >> 9, l = cm & 511; const size_t kvrow = (size_t)NPR + (size_t)b * 4608 + l;
            const f32x4 ck = __builtin_nontemporal_load((const f32x4*)(p.in[I_CCKV] + ((size_t)b * 512 + l) * 256 + 4 * lane));
            u32x2 w; w.x = cvtpk(ck.x, ck.y); w.y = cvtpk(ck.z, ck.w); *(u32x2*)(CKV + kvrow * 256 + 4 * lane) = w;
            KR[kvrow * 64 + lane] = f2bf(p.in[I_CKR][((size_t)b * 512 + l) * 64 + lane]);
        }
    }
}

__device__ __forceinline__ void final_norm_phase(const Params& p, int gwb, int nwb, int lo0, int hi0, int lo1, int hi1) {
    const int lane = threadIdx.x & 63, wave = threadIdx.x >> 6;
    const int gw = gwb * NWAVES + wave, NGW = nwb * NWAVES, n0_ = hi0 - lo0, total = n0_ + (hi1 - lo1);
    const float* g = p.in[I_FING]; const bf16_t* X2 = (const bf16_t*)(p.ws + WS_X2B);
    f32x4 gv[4];
#pragma unroll
    for (int j = 0; j < 4; ++j) gv[j] = *(const f32x4*)(g + 4 * lane + 256 * j);
    for (int i0 = gw; i0 < total; i0 += 2 * NGW) {
        const bool has1 = i0 + NGW < total; const int i1 = has1 ? i0 + NGW : i0;
        const int m0 = i0 < n0_ ? lo0 + i0 : lo1 + (i0 - n0_), m1 = i1 < n0_ ? lo0 + i1 : lo1 + (i1 - n0_);
        f32x4 v0[4], v1[4];
#pragma unroll
        for (int j = 0; j < 4; ++j) { const int c = 4 * lane + 256 * j; v0[j] = ld_row4(nullptr, X2 + (size_t)m0 * DM, c); v1[j] = ld_row4(nullptr, X2 + (size_t)m1 * DM, c); }
        float s0 = 0.f, s1 = 0.f;
#pragma unroll
        for (int j = 0; j < 4; ++j) { s0 += (v0[j].x * v0[j].x + v0[j].y * v0[j].y) + (v0[j].z * v0[j].z + v0[j].w * v0[j].w); s1 += (v1[j].x * v1[j].x + v1[j].y * v1[j].y) + (v1[j].z * v1[j].z + v1[j].w * v1[j].w); }
#pragma unroll
        for (int o = 1; o < 64; o <<= 1) { s0 += __shfl_xor(s0, o); s1 += __shfl_xor(s1, o); }
        const float r0 = rsqrtf(s0 * (1.f / DM) + EPS), r1 = rsqrtf(s1 * (1.f / DM) + EPS);
#pragma unroll
        for (int j = 0; j < 4; ++j) { const int c = 4 * lane + 256 * j;
            __builtin_nontemporal_store((v0[j] * r0) * gv[j], (f32x4*)(p.out + (size_t)m0 * DM + c)); if (has1) __builtin_nontemporal_store((v1[j] * r1) * gv[j], (f32x4*)(p.out + (size_t)m1 * DM + c)); }
    }
}

#define XB_TMO      128
#define XB_XCNT(j)  (256  + 64 * (j))
#define XB_XSUB(j)  (1280 + 64 * (j))
#define XB_XGEN(j)  (2304 + 64 * (j))
#define XB_TOP      3328
#define XB_TOPGEN   3392
#define XCD_BAR_WORDS 3456
#define XB_SPIN_CAP (1u << 18)

__device__ __forceinline__ unsigned xb_ld(unsigned* p)              { return __hip_atomic_load(p, __ATOMIC_RELAXED, __HIP_MEMORY_SCOPE_AGENT); }
__device__ __forceinline__ unsigned xb_add(unsigned* p, unsigned v) { return __hip_atomic_fetch_add(p, v, __ATOMIC_RELAXED, __HIP_MEMORY_SCOPE_AGENT); }
__device__ __forceinline__ unsigned xb_xcc_id() { return (unsigned)__builtin_amdgcn_s_getreg((3 << 11) | 20) & 0xFu; }
#define XB_SPIN(cond, bar) do { unsigned _sp = 0; while (cond) { __builtin_amdgcn_s_sleep(1); \
    if ((++_sp & 255u) == 0u) { if (xb_ld(&(bar)[XB_TMO])) break; if (_sp > XB_SPIN_CAP) { atomicAdd(&(bar)[XB_TMO], 1u); break; } } } } while (0)

struct XcdBarrier {
    unsigned* bar; unsigned x;
    volatile LAS unsigned* st;
};

__device__ __forceinline__ XcdBarrier xcd_barrier_post(unsigned* bar, volatile LAS unsigned* st) {
    XcdBarrier b; b.bar = bar; b.x = xb_xcc_id(); b.st = st;
    if (threadIdx.x == 0) (void)xb_add(&bar[XB_XCNT(b.x)], 1u);
    return b;
}
__device__ __forceinline__ void xcd_barrier_complete(unsigned* bar, unsigned x, unsigned& nloc, unsigned& nx) {
    const unsigned G = gridDim.x * gridDim.y * gridDim.z;
    unsigned sum, cnt, mine, sp = 0u;
    for (;;) {
        sum = 0u; cnt = 0u; mine = 0u;
#pragma unroll
        for (unsigned j = 0; j < 16; ++j) { const unsigned c = xb_ld(&bar[XB_XCNT(j)]); sum += c; cnt += (c > 0u) ? 1u : 0u; mine = (j == x) ? c : mine; }
        if (sum == G) break;
        __builtin_amdgcn_s_sleep(1);
        if ((++sp & 255u) == 0u) { if (xb_ld(&bar[XB_TMO])) break; if (sp > XB_SPIN_CAP) { atomicAdd(&bar[XB_TMO], 1u); break; } }
    }
    nloc = mine > 0u ? mine : 1u; nx = cnt > 0u ? cnt : 1u;
}

__device__ __forceinline__ void xcd_barrier(const XcdBarrier& b) {
    asm volatile("s_waitcnt vmcnt(0)" ::: "memory");
    __syncthreads();
    if (threadIdx.x == 0) {
        unsigned* bar = b.bar;
        __builtin_amdgcn_s_waitcnt(0);
        unsigned nloc = b.st[0], nx = b.st[1];
        if (nloc == 0u) { xcd_barrier_complete(bar, b.x, nloc, nx); b.st[0] = nloc; b.st[1] = nx; }
        const unsigned old = xb_add(&bar[XB_XSUB(b.x)], 1u);
        const unsigned gen = old / nloc;
        if (old + 1u == (gen + 1u) * nloc) {
            __builtin_amdgcn_fence(__ATOMIC_RELEASE, "agent");
            asm volatile("s_waitcnt vmcnt(0)" ::: "memory");
            const unsigned og = xb_add(&bar[XB_TOP], 1u);
            const unsigned tg = og / nx;
            if (og + 1u == (tg + 1u) * nx) xb_add(&bar[XB_TOPGEN], 1u);
            else XB_SPIN(xb_ld(&bar[XB_TOPGEN]) == tg, bar);
            __builtin_amdgcn_fence(__ATOMIC_ACQUIRE, "agent");
            xb_add(&bar[XB_XGEN(b.x)], 1u);
            asm volatile("s_waitcnt vmcnt(0)" ::: "memory");
        } else {
            XB_SPIN(xb_ld(&bar[XB_XGEN(b.x)]) == gen, bar);
            __builtin_amdgcn_fence(__ATOMIC_ACQUIRE, "agent");
            asm volatile("s_waitcnt vmcnt(0)" ::: "memory");
        }
    }
    __syncthreads();
}

namespace att {
constexpr int NW = 8, QBLK = 32, KVBLK = 64;
constexpr float SCALE = 0.07216878364870322f;
constexpr float THR = 8.f;
constexpr int SDEPTH = 1;
constexpr int LDQ = 1536, LDK = 2048, LDR = 64, LDO = 1024;
constexpr int SHM_V = KVBLK * 128 * 2, SHM_K = KVBLK * 192 * 2;
constexpr int NQR = 6;
constexpr int SHM_ATTN = 2 * SHM_V + 2 * SHM_K + NW * 64 * 4 + NW * (12 - NQR) * 1024;
#define KSWZ(row, colB) ((row) * 384 + ((colB) ^ (((row) & 7) << 4)))
#define SBAR() __builtin_amdgcn_sched_barrier(0)
__device__ __forceinline__ unsigned cvtpk_a(float lo, float hi) { unsigned r; asm volatile("v_cvt_pk_bf16_f32 %0, %1, %2" : "=v"(r) : "v"(lo), "v"(hi)); return r; }

__device__ __forceinline__ void partialSM(f32x16& p0, f32x16& p1, float& m_reg, float& mn, float& alpha) {
  constexpr float C = SCALE * 1.4426950408889634f;
  float pmax = p0[0];
#pragma unroll
  for (int r = 1; r < 16; ++r) pmax = fmaxf(pmax, p0[r]);
#pragma unroll
  for (int r = 0; r < 16; ++r) pmax = fmaxf(pmax, p1[r]);
  { auto rr = __builtin_amdgcn_permlane32_swap(__float_as_uint(pmax), __float_as_uint(pmax), false, false);
    pmax = fmaxf(__uint_as_float(rr[0]), __uint_as_float(rr[1])); }
  if (__builtin_expect(__all(pmax - m_reg <= THR / SCALE), 1)) { mn = m_reg; alpha = 1.f; }
  else { mn = fmaxf(m_reg, pmax); alpha = __builtin_amdgcn_exp2f((m_reg - mn) * C); m_reg = mn; }
  float mnC = -mn * C;
#pragma unroll
  for (int r = 0; r < 16; ++r) p0[r] = fmaf(p0[r], C, mnC);
#pragma unroll
  for (int r = 0; r < 16; ++r) p1[r] = fmaf(p1[r], C, mnC);
#pragma unroll
  for (int r = 0; r < 16; ++r) p0[r] = __builtin_amdgcn_exp2f(p0[r]);
}
__device__ __forceinline__ void finishSM(f32x16& p0, f32x16& p1, float alpha, float& l_reg, bf16x8& pa0, bf16x8& pa1, bf16x8& pa2, bf16x8& pa3) {
#pragma unroll
  for (int r = 0; r < 16; ++r) p1[r] = __builtin_amdgcn_exp2f(p1[r]);
  float ps = 0;
#pragma unroll
  for (int r = 0; r < 16; ++r) ps += p0[r];
#pragma unroll
  for (int r = 0; r < 16; ++r) ps += p1[r];
  { auto rr = __builtin_amdgcn_permlane32_swap(__float_as_uint(ps), __float_as_uint(ps), false, false);
    ps = __uint_as_float(rr[0]) + __uint_as_float(rr[1]); }
  l_reg = l_reg * alpha + ps;
#define PK4(P, BASE, OUT) do { unsigned a0 = cvtpk_a(P[BASE + 0], P[BASE + 1]), a1 = cvtpk_a(P[BASE + 2], P[BASE + 3]);   \
    unsigned b0 = cvtpk_a(P[BASE + 4], P[BASE + 5]), b1 = cvtpk_a(P[BASE + 6], P[BASE + 7]);                              \
    auto r0 = __builtin_amdgcn_permlane32_swap(a0, b0, false, false); auto r1 = __builtin_amdgcn_permlane32_swap(a1, b1, false, false); \
    u32x4 w = {r0[0], r1[0], r0[1], r1[1]}; OUT = *reinterpret_cast<bf16x8*>(&w); } while (0)
  PK4(p0, 0, pa0); PK4(p0, 8, pa1); PK4(p1, 0, pa2); PK4(p1, 8, pa3);
#undef PK4
}
__device__ __forceinline__ void qkt(f32x16& p0, f32x16& p1, const char* Ks, const bf16x8* qr, const char* qlds, int r32, int hi) {
  p0 = f32x16{}; p1 = f32x16{};
#pragma unroll
  for (int d0 = 0; d0 < 12; ++d0) { int cb = (d0 * 16 + hi * 8) * 2;
    bf16x8 b0 = *reinterpret_cast<const bf16x8*>(Ks + KSWZ(r32, cb));
    bf16x8 b1 = *reinterpret_cast<const bf16x8*>(Ks + KSWZ(32 + r32, cb));
    const bf16x8 qf = d0 < NQR ? qr[d0 < NQR ? d0 : 0] : *reinterpret_cast<const bf16x8*>(qlds + (d0 - NQR) * 1024);
    p0 = __builtin_amdgcn_mfma_f32_32x32x16_bf16(b0, qf, p0, 0, 0, 0);
    p1 = __builtin_amdgcn_mfma_f32_32x32x16_bf16(b1, qf, p1, 0, 0, 0); }
}
__device__ __forceinline__ int v_st(int k, int c) { const int kk = (k & ~0xC) | ((k & 4) << 1) | ((k & 8) >> 1); return ((kk >> 3) * 4 + (c >> 5)) * 512 + ((kk & 7) * 32 + (c & 31)) * 2; }
__device__ __forceinline__ int v_rd_base(int lane) { return ((lane & 3) << 3) | (((lane >> 2) & 3) << 6) | (((lane >> 4) & 1) << 5) | (((lane >> 5) & 1) << 8); }
constexpr int v_rd_off(int d0, int ks, int half) { return d0 * 512 + ks * 4096 + half * 2048; }
template <int OFF> __device__ __forceinline__ s16x4 tr_read(int vb) {
  s16x4 r; asm volatile("ds_read_b64_tr_b16 %0, %1 offset:%2" : "=&v"(r) : "v"(vb), "i"(OFF) : "memory"); return r;
}
template <int D0> __device__ __forceinline__ void pv_one(f32x16& od, int vb, bf16x8 pa0, bf16x8 pa1, bf16x8 pa2, bf16x8 pa3) {
  const s16x4 l0 = tr_read<v_rd_off(D0, 0, 0)>(vb), h0 = tr_read<v_rd_off(D0, 0, 1)>(vb), l1 = tr_read<v_rd_off(D0, 1, 0)>(vb), h1 = tr_read<v_rd_off(D0, 1, 1)>(vb);
  const s16x4 l2 = tr_read<v_rd_off(D0, 2, 0)>(vb), h2 = tr_read<v_rd_off(D0, 2, 1)>(vb), l3 = tr_read<v_rd_off(D0, 3, 0)>(vb), h3 = tr_read<v_rd_off(D0, 3, 1)>(vb);
  asm volatile("s_waitcnt lgkmcnt(0)" ::: "memory"); SBAR();
#define PK(Lx, Hx) (bf16x8){Lx[0], Lx[1], Lx[2], Lx[3], Hx[0], Hx[1], Hx[2], Hx[3]}
  od = __builtin_amdgcn_mfma_f32_32x32x16_bf16(pa0, PK(l0, h0), od, 0, 0, 0);
  od = __builtin_amdgcn_mfma_f32_32x32x16_bf16(pa1, PK(l1, h1), od, 0, 0, 0);
  od = __builtin_amdgcn_mfma_f32_32x32x16_bf16(pa2, PK(l2, h2), od, 0, 0, 0);
  od = __builtin_amdgcn_mfma_f32_32x32x16_bf16(pa3, PK(l3, h3), od, 0, 0, 0);
#undef PK
}
__device__ __forceinline__ void pv_d0(f32x16* o, int vb, bf16x8 pa0, bf16x8 pa1, bf16x8 pa2, bf16x8 pa3) {
  pv_one<0>(o[0], vb, pa0, pa1, pa2, pa3); pv_one<1>(o[1], vb, pa0, pa1, pa2, pa3); pv_one<2>(o[2], vb, pa0, pa1, pa2, pa3); pv_one<3>(o[3], vb, pa0, pa1, pa2, pa3);
}

constexpr int NSLOT = 3, LDS_KR = 0, LDS_VR = NSLOT * SHM_K, LDS_SC = LDS_VR + NSLOT * SHM_V, LDS_Q11 = LDS_SC + NW * 64 * 4, ATT_LDS = LDS_Q11 + NW * 1024;
#define ATT_WAITBAR(N) asm volatile("s_waitcnt vmcnt(" #N ") lgkmcnt(0)\n\ts_barrier" ::: "memory")
__device__ __forceinline__ void qkt3(f32x16& p0, f32x16& p1, const LAS char* Ks, const bf16x8* qr, int baseN, int XN, int baseR, int XR) {
  p0 = f32x16{}; p1 = f32x16{};
#pragma unroll
  for (int d0 = 0; d0 < 8; ++d0) { const int ad = baseN + ((32 * d0) ^ XN);
    bf16x8 b0 = *reinterpret_cast<const LAS bf16x8*>(Ks + ad);
    bf16x8 b1 = *reinterpret_cast<const LAS bf16x8*>(Ks + ad + 8192);
    p0 = __builtin_amdgcn_mfma_f32_32x32x16_bf16(b0, qr[d0], p0, 0, 0, 0);
    p1 = __builtin_amdgcn_mfma_f32_32x32x16_bf16(b1, qr[d0], p1, 0, 0, 0); }
#pragma unroll
  for (int d0 = 8; d0 < 12; ++d0) { const int ad = baseR + ((32 * (d0 - 8)) ^ XR);
    bf16x8 b0 = *reinterpret_cast<const LAS bf16x8*>(Ks + ad);
    bf16x8 b1 = *reinterpret_cast<const LAS bf16x8*>(Ks + ad + 4096);
    p0 = __builtin_amdgcn_mfma_f32_32x32x16_bf16(b0, qr[d0], p0, 0, 0, 0);
    p1 = __builtin_amdgcn_mfma_f32_32x32x16_bf16(b1, qr[d0], p1, 0, 0, 0); }
}
#define LDK128(dst, addr, OFFS) asm volatile("ds_read_b128 %0, %1 offset:%2" : "=&v"(dst) : "v"(addr), "n"(OFFS) : "memory")
#define LWAIT0() asm volatile("s_waitcnt lgkmcnt(0)" ::: "memory")
#define KAD(d0) ((d0) < 8 ? (unsigned)(ksl + baseN + ((32 * (d0)) ^ XN)) : (unsigned)(ksl + baseR + ((32 * ((d0) - 8)) ^ XR)))
#define KISSUE(F, j0) do { _Pragma("unroll") for (int t_ = 0; t_ < 3; ++t_) { const unsigned ad_ = KAD((j0) + t_); \
    if ((j0) + t_ < 8) { LDK128(F[2 * t_], ad_, 0); LDK128(F[2 * t_ + 1], ad_, 8192); } else { LDK128(F[2 * t_], ad_, 0); LDK128(F[2 * t_ + 1], ad_, 4096); } } } while (0)
#define KMFMA(F, j0) do { _Pragma("unroll") for (int t_ = 0; t_ < 3; ++t_) { \
    p0 = __builtin_amdgcn_mfma_f32_32x32x16_bf16(F[2 * t_], qr[(j0) + t_], p0, 0, 0, 0); p1 = __builtin_amdgcn_mfma_f32_32x32x16_bf16(F[2 * t_ + 1], qr[(j0) + t_], p1, 0, 0, 0); } } while (0)
#define QK_HEAD(FA) KISSUE(FA, 0)
#define QK_BODY(FA, FB) do { p0 = f32x16{}; p1 = f32x16{}; \
    SBAR(); LWAIT0(); KISSUE(FB, 3); SBAR(); KMFMA(FA, 0); \
    SBAR(); LWAIT0(); KISSUE(FA, 6); SBAR(); KMFMA(FB, 3); \
    SBAR(); LWAIT0(); KISSUE(FB, 9); SBAR(); KMFMA(FA, 6); \
    SBAR(); LWAIT0(); SBAR(); KMFMA(FB, 9); SBAR(); } while (0)
#define VISSUE(Lx, Hx, D0) do { Lx[0] = tr_read<v_rd_off(D0, 0, 0)>(vb); Hx[0] = tr_read<v_rd_off(D0, 0, 1)>(vb); Lx[1] = tr_read<v_rd_off(D0, 1, 0)>(vb); Hx[1] = tr_read<v_rd_off(D0, 1, 1)>(vb); \
    Lx[2] = tr_read<v_rd_off(D0, 2, 0)>(vb); Hx[2] = tr_read<v_rd_off(D0, 2, 1)>(vb); Lx[3] = tr_read<v_rd_off(D0, 3, 0)>(vb); Hx[3] = tr_read<v_rd_off(D0, 3, 1)>(vb); } while (0)
#define VPK(Lx, Hx, i) (bf16x8){Lx[i][0], Lx[i][1], Lx[i][2], Lx[i][3], Hx[i][0], Hx[i][1], Hx[i][2], Hx[i][3]}
#define VMFMA(od, Lx, Hx) do { od = __builtin_amdgcn_mfma_f32_32x32x16_bf16(pa0, VPK(Lx, Hx, 0), od, 0, 0, 0); od = __builtin_amdgcn_mfma_f32_32x32x16_bf16(pa1, VPK(Lx, Hx, 1), od, 0, 0, 0); \
    od = __builtin_amdgcn_mfma_f32_32x32x16_bf16(pa2, VPK(Lx, Hx, 2), od, 0, 0, 0); od = __builtin_amdgcn_mfma_f32_32x32x16_bf16(pa3, VPK(Lx, Hx, 3), od, 0, 0, 0); } while (0)
__device__ __forceinline__ void attn_unit(const bf16_t* __restrict__ Qb, const bf16_t* __restrict__ Kn, const bf16_t* __restrict__ Vh, const bf16_t* __restrict__ Kr,
                                          const bf16_t* Gi, bf16_t* Go, int seq, LAS unsigned char* L, const f32x2* __restrict__ tab, int t0) {
  const int tid = threadIdx.x, wid = __builtin_amdgcn_readfirstlane(tid >> 6), lane = tid & 63, r32 = lane & 31, hi = lane >> 5;
  const LAS char* K_lds = (const LAS char*)L + LDS_KR;
  LAS float* ws = (LAS float*)(L + LDS_SC) + wid * 64; LAS float* li_l = ws; LAS float* al_l = ws + 32;
  const char* kp[3]; int kst[3]; const char* vp[2];
#pragma unroll
  for (int i = 0; i < 2; ++i) { const int o = (wid + 8 * i) * 1024 + lane * 16, row = o >> 8, s = (o >> 4) & 15, c4 = s ^ ((row & 7) | (((row >> 4) & 1) << 3));
    kp[i] = (const char*)(Kn + (long)row * LDK + c4 * 8); kst[i] = KVBLK * LDK * 2; }
  { const int o = wid * 1024 + lane * 16, line = o >> 8, s = (o >> 4) & 15, row = 32 * (line >> 4) + 16 * (s >> 3) + (line & 15), c4 = (s & 7) ^ (row & 7);
    kp[2] = (const char*)(Kr + (long)row * LDR + c4 * 8); kst[2] = KVBLK * LDR * 2; }
  const int gq = (r32 & 7) | (((r32 >> 4) & 1) << 3);
  const int baseN = r32 * 256, XN = 16 * (hi ^ gq), baseR = 16384 + (r32 & 15) * 256 + 128 * ((r32 >> 4) & 1), XR = 16 * (hi ^ (r32 & 7));
#pragma unroll
  for (int i = 0; i < 2; ++i) { const int o = (wid + 8 * i) * 1024 + lane * 16, sub = o >> 9, kk = (sub >> 2) * 8 + ((o & 511) >> 6), c = (sub & 3) * 32 + ((o & 63) >> 1);
    const int k = (kk & ~0xC) | ((kk & 4) << 1) | ((kk & 8) >> 1); vp[i] = (const char*)(Vh + (long)k * LDK + c); }
#define DMA_K(slot) do { _Pragma("unroll") for (int i_ = 0; i_ < 3; ++i_) { __builtin_amdgcn_global_load_lds((const unsigned*)kp[i_], (LAS unsigned*)(L + LDS_KR + (slot) * SHM_K + (wid + 8 * i_) * 1024), 16, 0, 0); kp[i_] += kst[i_]; } } while (0)
#define DMA_V(slot) do { _Pragma("unroll") for (int i_ = 0; i_ < 2; ++i_) { __builtin_amdgcn_global_load_lds((const unsigned*)vp[i_], (LAS unsigned*)(L + LDS_VR + (slot) * SHM_V + (wid + 8 * i_) * 1024), 16, 0, 0); vp[i_] += KVBLK * LDK * 2; } } while (0)
  const int NT = seq / KVBLK;
  DMA_K(0); DMA_V(0); DMA_K(1); DMA_V(1);
  float m_reg = -1e30f, l_reg = 0; f32x16 o[4] = {}; bf16x8 qr[12];
  const bf16_t* Qw = Qb + (long)(wid * QBLK + r32) * LDQ + hi * 8;
#pragma unroll
  for (int d0 = 0; d0 < 8; ++d0) qr[d0] = *reinterpret_cast<const bf16x8*>(Qw + d0 * 16);
  {
    u32x4 qp[4];
#pragma unroll
    for (int d0 = 0; d0 < 4; ++d0) qp[d0] = *reinterpret_cast<const u32x4*>(Qw + 128 + d0 * 16);
    if (t0 >= 0) { const int t = t0 + wid * QBLK + r32;
#pragma unroll
      for (int pr = 0; pr < 2; ++pr) { const int pos = pr == 0 ? (t >> 6) : (t & 63); const f32x2* tp = tab + pos * 16 + hi * 8;
#pragma unroll
        for (int e2 = 0; e2 < 4; ++e2) { const f32x2 c0 = tp[2 * e2], c1 = tp[2 * e2 + 1];
          const float a0 = bflo(qp[2 * pr][e2]), a1 = bfhi(qp[2 * pr][e2]), b0 = bflo(qp[2 * pr + 1][e2]), b1 = bfhi(qp[2 * pr + 1][e2]);
          qp[2 * pr][e2] = cvtpk(a0 * c0.x - b0 * c0.y, a1 * c1.x - b1 * c1.y); qp[2 * pr + 1][e2] = cvtpk(a0 * c0.y + b0 * c0.x, a1 * c1.y + b1 * c1.x); } } }
#pragma unroll
    for (int d0 = 0; d0 < 3; ++d0) qr[8 + d0] = __builtin_bit_cast(bf16x8, qp[d0]);
    *(LAS u32x4*)(L + LDS_Q11 + wid * 1024 + lane * 16) = qp[3]; }
  const int vb0 = (int)(unsigned)(uintptr_t)(L + LDS_VR) + v_rd_base(lane);
#define RESC(a) do { if (__any((a) < 1.f)) { if (hi == 0) al_l[r32] = (a); asm volatile("s_waitcnt lgkmcnt(0)" ::: "memory"); \
    _Pragma("unroll") for (int d = 0; d < 4; ++d) _Pragma("unroll") for (int r = 0; r < 16; ++r) o[d][r] *= al_l[crow(r, hi)]; } } while (0)
  ATT_WAITBAR(0);
  if (wid >= 4) ATT_WAITBAR(0);
  int sj = 0;
#pragma unroll 1
  for (int j = 0; j < NT; ++j) {
    f32x16 p0, p1; float mnC, alC;
    {
      const unsigned ksl = (unsigned)(uintptr_t)(K_lds + sj * SHM_K);
      bf16x8 FA[6], FB[6];
      qr[11] = *(const LAS bf16x8*)(L + LDS_Q11 + wid * 1024 + lane * 16);
      QK_HEAD(FA);
      QK_BODY(FA, FB);
      partialSM(p0, p1, m_reg, mnC, alC);
      RESC(alC); }
    ATT_WAITBAR(0);
    {
      const int vb = vb0 + sj * SHM_V;
      s16x4 LA[4], HA[4], LB[4], HB[4]; bf16x8 pa0, pa1, pa2, pa3;
      VISSUE(LA, HA, 0);
      if (j + 2 < NT) { const int s2 = sj == 0 ? 2 : sj - 1; DMA_V(s2); DMA_K(s2); }
      SBAR(); finishSM(p0, p1, alC, l_reg, pa0, pa1, pa2, pa3); SBAR();
      LWAIT0(); VISSUE(LB, HB, 1); SBAR(); VMFMA(o[0], LA, HA);
      SBAR(); LWAIT0(); VISSUE(LA, HA, 2); SBAR(); VMFMA(o[1], LB, HB);
      SBAR(); LWAIT0(); VISSUE(LB, HB, 3); SBAR(); VMFMA(o[2], LA, HA);
      SBAR(); LWAIT0(); SBAR(); VMFMA(o[3], LB, HB); }
    if (j + 2 < NT) ATT_WAITBAR(5); else ATT_WAITBAR(0);
    sj = sj == 2 ? 0 : sj + 1;
  }
  if (wid < 4) ATT_WAITBAR(0);
  if (hi == 0) li_l[r32] = l_reg; asm volatile("s_waitcnt lgkmcnt(0)" ::: "memory");
  unsigned stg_a = (unsigned)(uintptr_t)(L + wid * 8192); asm volatile("" : "+v"(stg_a));
  int lane_e = lane; asm volatile("" : "+v"(lane_e));
  LAS char* stg = (LAS char*)(uintptr_t)(stg_a + (unsigned)(((lane_e >> 5) * 4 * 128 + (lane_e & 31)) * 2));
#pragma unroll
  for (int r = 0; r < 16; ++r) { const float rl = __builtin_amdgcn_rcpf(li_l[crow(r, hi)]);
#pragma unroll
    for (int d0 = 0; d0 < 4; ++d0) *(LAS bf16_t*)(stg + ((r & 3) + 8 * (r >> 2)) * 256 + d0 * 64) = f2bf(o[d0][r] * rl); }
  stg = (LAS char*)(uintptr_t)stg_a;
  asm volatile("s_waitcnt lgkmcnt(0)" ::: "memory");
  { const bf16_t* Gw = Gi + (long)(wid * QBLK) * LDO; bf16_t* Ow = Go + (long)(wid * QBLK) * LDO;
#pragma unroll 1
    for (int ib_ = 0; ib_ < 2; ++ib_) {
      u32x4 gt[4];
#pragma unroll
      for (int i = 0; i < 4; ++i) { const int n = lane + 64 * (4 * ib_ + i); gt[i] = *(const u32x4*)(Gw + (long)(n >> 4) * LDO + (n & 15) * 8); }
#pragma unroll
      for (int i = 0; i < 4; ++i) { const int n = lane + 64 * (4 * ib_ + i); const u32x4 ov = *(const LAS u32x4*)(stg + n * 16); const u32x4 g = gt[i]; u32x4 w;
        w.x = cvtpk(bflo(ov.x) * silu_f(bflo(g.x)), bfhi(ov.x) * silu_f(bfhi(g.x))); w.y = cvtpk(bflo(ov.y) * silu_f(bflo(g.y)), bfhi(ov.y) * silu_f(bfhi(g.y)));
        w.z = cvtpk(bflo(ov.z) * silu_f(bflo(g.z)), bfhi(ov.z) * silu_f(bfhi(g.z))); w.w = cvtpk(bflo(ov.w) * silu_f(bflo(g.w)), bfhi(ov.w) * silu_f(bfhi(g.w)));
        *(u32x4*)(Ow + (long)(n >> 4) * LDO + (n & 15) * 8) = w; } } }
  asm volatile("s_waitcnt vmcnt(0) lgkmcnt(0)\n\ts_barrier" ::: "memory");
#undef DMA_K
#undef DMA_V
#undef RESC
#undef ROT
#undef STEP
}
#undef SBAR
}

__device__ __forceinline__ void attn_phase(const Params& p, LAS unsigned char* lds, int G, bool dummy) {
    const bf16_t* Q = (const bf16_t*)(p.ws + WS_LATQ); const bf16_t* KV = (const bf16_t*)(p.ws + WS_KV); const bf16_t* KR = (const bf16_t*)(p.ws + WS_KR); bf16_t* GT = (bf16_t*)(p.ws + WS_GATE);
    for (int u = blockIdx.x; u < 1280; u += G) {
        size_t qrow, krow; int hh, seq, t0;
        if (u < 1024) { const int v = u & 255, k = u >> 8, xcd = v & 7, idx = v >> 3; const int bh = k * 16 + xcd * 2 + (idx >> 4), qb = idx & 15; const int b = bh >> 3; hh = bh & 7;
            qrow = (size_t)NPR + (size_t)b * 4096 + (size_t)qb * 256; krow = (size_t)NPR + (size_t)b * 4608; seq = 4608; t0 = qb * 256; }
        else { const int pu = u - 1024; const int b = pu >> 3; hh = pu & 7; qrow = (size_t)b * 256; krow = qrow; seq = 256; t0 = -1; }
        att::attn_unit(Q + qrow * 1536 + hh * 192, KV + krow * 2048 + hh * 256, KV + krow * 2048 + hh * 256 + 128, KR + krow * 64, GT + qrow * 1024 + hh * 128, dummy ? (bf16_t*)(p.ws + WS_ACT + 64 * MiB) : GT + qrow * 1024 + hh * 128, seq, lds, (const f32x2*)(p.ws + WS_TAB), t0);
    }
}

#ifndef MK_SINGLE
#define MK_SINGLE 1
#endif
constexpr int N_PHASES = 14;
struct KArgs { Params p; int ph_lo, ph_hi; };

__global__ void __launch_bounds__(NTHREADS, 2) mk_fwd(KArgs a) {
    extern __shared__ __attribute__((aligned(16))) unsigned char lds[];
    cg::grid_group grid = cg::this_grid();
    const Params& p = a.p; const int G = gridDim.x;
    LAS char* L = (LAS char*)lds;
    volatile LAS unsigned* MISC = (volatile LAS unsigned*)((LAS unsigned char*)lds + 147456 - 128);
    if (threadIdx.x < 16) MISC[threadIdx.x] = 0u;
    if (blockIdx.x == 0) { unsigned* bw = (unsigned*)(p.ws + WS_BAR);
        for (int i = threadIdx.x; i < XCD_BAR_WORDS; i += NTHREADS) __hip_atomic_store(bw + i, 0u, __ATOMIC_RELAXED, __HIP_MEMORY_SCOPE_AGENT);
        asm volatile("s_waitcnt vmcnt(0)" ::: "memory"); }
    __syncthreads();
    XcdBarrier bar; bar.bar = (unsigned*)(p.ws + WS_BAR); bar.x = 0; bar.st = MISC + 8;
    unsigned char* ws = p.ws;
    float* mod = (float*)(ws + WS_MOD);
    bf16_t* ACT = (bf16_t*)(ws + WS_ACT);
#ifndef PH
#define PH -1
#endif
#define IN(k) ((PH < 0 || PH == (k)) && a.ph_lo <= (k) && (k) < a.ph_hi)
#ifndef DUPMASK
#define DUPMASK 0
#endif
#define DUP(k) (((DUPMASK) >> (k)) & 1)
#define SEAM(k) do { if (a.ph_lo <= (k) && (k) + 1 < a.ph_hi) { if ((k) == 0) grid.sync(); else xcd_barrier(bar); } } while (0)
#define RUN_GEMM(EPI, Aptr, Bptr, M_, N_, K_, ...) do { pg8::Gemm g{(const bf16_t*)(Aptr), (const bf16_t*)(Bptr), (M_), (N_), (K_)}; pg8::StaticOrder S; S.init((M_), (N_), G, (int)blockIdx.x); \
        pg8::EPI E{__VA_ARGS__}; pg8::gemm_phase<pg8::EPI, pg8::StaticOrder, true, true>((PG8_LAS unsigned char*)lds, g, S, E); } while (0)

#ifdef NSYNC_EXTRA
    for (int i_ = 0; i_ < NSYNC_EXTRA; ++i_) grid.sync();
#endif
    if (IN(0)) { if (DUP(0)) { p0_phase(p, L, G); grid.sync(); } p0_phase(p, L, G); }
    SEAM(0);
    if (a.ph_lo <= 0 && 1 < a.ph_hi) bar = xcd_barrier_post((unsigned*)(p.ws + WS_BAR), MISC + 8);
    if (IN(1)) norm_mod_phase(p.in[I_XP], p.in[I_XS], nullptr, p.in[I_NORMG], mod, ACT, (int)blockIdx.x, G, 0, MROWS, 0, 0);
    SEAM(1);
    if (IN(2)) { if (DUP(2)) { RUN_GEMM(EpiBf16S, ACT, ws + WS_W_EIN, MROWS, 4096, 1024, (bf16_t*)(ws + WS_P), PP, 2, 4, 0.08838834764831845f, 1 << 30, nullptr, 0, 8, 2048); grid.sync(); } RUN_GEMM(EpiBf16S, ACT, ws + WS_W_EIN, MROWS, 4096, 1024, (bf16_t*)(ws + WS_P), PP, 2, 4, 0.08838834764831845f, 1 << 30, nullptr, 0, 8, 2048); }
    SEAM(2);
    if (IN(3)) ret_local_phase(p, L, G);
    SEAM(3);
    if (IN(4)) ret_scan2_phase(p, G);
    SEAM(4);
    if (IN(5)) { if (DUP(5)) { ret_out_phase(p, L, G); grid.sync(); } ret_out_phase(p, L, G); }
    SEAM(5);
#define RUN_PART(PM0, MSUB, GS, XP_, XS_, B16_, O16_, MODL_, Aptr, Bptr) do { pg8::Gemm g{(const bf16_t*)(Aptr) + (size_t)(PM0) * 256 * 1024, (const bf16_t*)(Bptr), (MSUB), 1024, 1024}; \
        pg8::StaticOrder S; S.init((MSUB), 1024, (GS), (int)blockIdx.x); pg8::EpiRes E{(XP_), (XS_), (B16_), (O16_), (MODL_), (PM0)}; \
        pg8::gemm_phase<pg8::EpiRes, pg8::StaticOrder, true, true>((PG8_LAS unsigned char*)lds, g, S, E); } while (0)
#define RUN_SPLIT(XP_, XS_, B16_, O16_, MODL_, Aptr, Bptr, OTHER) do { \
        RUN_PART(0, 32768, G, XP_, XS_, B16_, O16_, MODL_, Aptr, Bptr); \
        xcd_barrier(bar); \
        { const int Gs = G >> 1; if ((int)blockIdx.x < Gs) RUN_PART(128, MROWS - 32768, Gs, XP_, XS_, B16_, O16_, MODL_, Aptr, Bptr); else { OTHER; } } } while (0)
    if (IN(6)) RUN_SPLIT(p.in[I_XP], p.in[I_XS], nullptr, (bf16_t*)p.out, mod, ACT, ws + WS_W_EOUT,
                         norm_mod_phase(nullptr, nullptr, (const bf16_t*)p.out, p.in[I_NORMG] + DM, mod + 9 * 3072, ACT, (int)blockIdx.x - Gs, G - Gs, 0, 32768, 0, 0));
    SEAM(6);
    if (IN(7)) norm_mod_phase(nullptr, nullptr, (const bf16_t*)p.out, p.in[I_NORMG] + DM, mod + 9 * 3072, ACT, (int)blockIdx.x, G, 32768, MROWS, 0, 0);
    SEAM(7);
    if (IN(8)) { if (DUP(8)) { RUN_GEMM(EpiBf16S, ACT, ws + WS_W_OIN, MROWS, 1792, 1024, (bf16_t*)(ws + WS_GATE), 1024, 0, 0, 1.f, 4, (bf16_t*)(ws + WS_LAT16), 768, 1 << 30, 0); grid.sync(); } RUN_GEMM(EpiBf16S, ACT, ws + WS_W_OIN, MROWS, 1792, 1024, (bf16_t*)(ws + WS_GATE), 1024, 0, 0, 1.f, 4, (bf16_t*)(ws + WS_LAT16), 768, 1 << 30, 0); }
    SEAM(8);
    if (IN(9)) { if (DUP(9)) { lat_phase(p, G); grid.sync(); } lat_phase(p, G); }
    SEAM(9);
    if (IN(10)) {
#pragma unroll 1
      for (int rep9 = DUP(10) ? 0 : 1; rep9 < 2; ++rep9) {
        RUN_GEMM(EpiBf16S, ws + WS_QN, ws + WS_W_QUP, MROWS, 1536, 384, (bf16_t*)(ws + WS_LATQ), 1536, 0, 0, 1.f, 1 << 30, nullptr, 0, 1 << 30, 0);
        RUN_GEMM(EpiBf16S, ws + WS_CKV, ws + WS_W_KVUP, KVROWS, 2048, 256, (bf16_t*)(ws + WS_KV), 2048, 0, 0, 1.f, 1 << 30, nullptr, 0, 1 << 30, 0);
        if (rep9 == 0) grid.sync(); }
    }
    SEAM(10);
    if (IN(11)) {
#if DUPMASK & (1 << 11)
#pragma unroll 1
        for (int rep = 0; rep < 2; ++rep) { attn_phase(p, (LAS unsigned char*)lds, G, rep == 0); if (rep == 0) xcd_barrier(bar); }
#else
        attn_phase(p, (LAS unsigned char*)lds, G, false);
#endif
    }
    SEAM(11);
    if (IN(12)) RUN_SPLIT(nullptr, nullptr, (const bf16_t*)p.out, (bf16_t*)(ws + WS_X2B), mod + 9 * 3072, ws + WS_GATE, ws + WS_W_OOUT,
                          final_norm_phase(p, (int)blockIdx.x - Gs, G - Gs, 0, 16384, 20480, 32768));
    SEAM(12);
    if (IN(13)) final_norm_phase(p, (int)blockIdx.x, G, 16384, 20480, 32768, MROWS);
#undef IN
#undef SEAM
#undef RUN_GEMM
}

extern "C" void kernel_launch(void* const* d_in, const int* in_sizes, int n_in, void* d_out, int out_size, void* d_ws, size_t ws_size, hipStream_t stream) {
    static int grid = 0;
    if (grid == 0) {
        if (n_in != 21 || in_sizes[0] != NPR * DM || in_sizes[1] != 32768 * DM || (size_t)out_size != OUT_TOTAL || ws_size < WS_END) {
            fprintf(stderr, "kernel_launch: unexpected shapes: n_in %d in0 %d in1 %d out %d ws %zu (need >= %zu)\n", n_in, n_in > 0 ? in_sizes[0] : -1, n_in > 1 ? in_sizes[1] : -1, out_size, ws_size, (size_t)WS_END);
            grid = -1; return; }
        int dev = 0, cus = 0, per_cu = 0;
        if (hipGetDevice(&dev) != hipSuccess || hipDeviceGetAttribute(&cus, hipDeviceAttributeMultiprocessorCount, dev) != hipSuccess) { fprintf(stderr, "kernel_launch: device query failed\n"); grid = -1; return; }
        if (hipFuncSetAttribute((const void*)mk_fwd, hipFuncAttributeMaxDynamicSharedMemorySize, LDS_BYTES) != hipSuccess) { fprintf(stderr, "kernel_launch: hipFuncSetAttribute failed\n"); grid = -1; return; }
        if (hipOccupancyMaxActiveBlocksPerMultiprocessor(&per_cu, (const void*)mk_fwd, NTHREADS, LDS_BYTES) != hipSuccess || per_cu < 1) { fprintf(stderr, "kernel_launch: occupancy query says %d blocks per CU\n", per_cu); (void)hipGetLastError(); grid = -1; return; }
        grid = cus * per_cu;
    }
    if (grid < 0) return;
    KArgs a{};
    for (int i = 0; i < 21; ++i) a.p.in[i] = (const float*)d_in[i];
    a.p.out = (float*)d_out; a.p.ws = (unsigned char*)d_ws;
#if MK_SINGLE
    a.ph_lo = 0; a.ph_hi = N_PHASES;
    void* args[] = {&a};
    hipError_t e = hipLaunchCooperativeKernel((const void*)mk_fwd, dim3(grid), dim3(NTHREADS), args, LDS_BYTES, stream);
    if (e != hipSuccess) fprintf(stderr, "kernel_launch: cooperative launch failed: %s (grid %d)\n", hipGetErrorString(e), grid);
#else
#ifndef HOSTDUP
#define HOSTDUP -1
#endif
    for (int k = 0; k < N_PHASES; ++k) { a.ph_lo = k; a.ph_hi = k + 1;
        hipLaunchKernelGGL(mk_fwd, dim3(grid), dim3(NTHREADS), LDS_BYTES, stream, a); }
#endif
}
```

```cpp
#include <hip/hip_runtime.h>
#include <hip/hip_cooperative_groups.h>
#include <cstdio>
#include <cstdint>
namespace cg = cooperative_groups;
namespace pg8 {
#define PG8_LAS __attribute__((address_space(3)))
typedef unsigned short bf16_t;
typedef short bf16x8 __attribute__((ext_vector_type(8)));
typedef float f32x4 __attribute__((ext_vector_type(4)));
typedef unsigned u32x4 __attribute__((ext_vector_type(4)));
constexpr int BM = 256, BK = 64, HALF = 128, HTB = HALF * BK * 2  , STAGE_BYTES = 8 * HTB, NXCD = 8, WGM = 8;

__host__ __device__ __forceinline__ int lds_byte(int r, int c) { const int st = (r >> 4) * 2 + (c >> 5), rr = r & 15, cc = c & 31, ob = rr * 64 + cc * 2; return st * 1024 + (ob ^ (((ob >> 9) & 1) << 5)); }
__host__ __device__ __forceinline__ void stage_rc(int b, int& R, int& C) { const int st = b / 1024, sb = b % 1024, swz = sb ^ (((sb >> 9) & 1) << 5); R = (st >> 1) * 16 + swz / 64; C = (st & 1) * 32 + (swz % 64) / 2; }
__host__ __device__ __forceinline__ int perm32(int rho) { const int n = rho >> 4, i = rho & 15; return 8 * (i >> 2) + 4 * n + (i & 3); }

struct Unit { int pm, pn; };
struct Gemm { const bf16_t* A; const bf16_t* Bt; int M, N, K; };

struct StaticOrder {
    int nM, nN, nwg, G, c;
    __host__ __device__ void init(int M, int N, int G_, int c_) { nM = M / BM; nN = N / BM; nwg = nM * nN; G = G_; c = c_; }
    __host__ __device__ bool next(int i, Unit& u) const {
        const long L = (long)i * G + c; if (L >= nwg) return false;
        int wgid = (int)L; { const int q = nwg / NXCD, r = nwg % NXCD, xcd = wgid % NXCD, off = wgid / NXCD; wgid = (xcd < r ? xcd * (q + 1) : r * (q + 1) + (xcd - r) * q) + off; }
        const int nig = WGM * nN, gid = wgid / nig, fm = gid * WGM, gsz = (nM - fm) < WGM ? (nM - fm) : WGM;
        u.pm = fm + ((wgid % nig) % gsz); u.pn = (wgid % nig) / gsz; return true;
    }
    __device__ __forceinline__ void a_ready(const Unit&) const {}
    __device__ __forceinline__ void done(const Unit&) const {}
};

__device__ __forceinline__ unsigned cvt_pk_bf16(float lo, float hi) { unsigned r; asm volatile("v_cvt_pk_bf16_f32 %0, %1, %2" : "=v"(r) : "v"(lo), "v"(hi)); return r; }
typedef float f32x2 __attribute__((ext_vector_type(2)));
template <class Epi, class Sched, bool ALIGN_EPI = false, bool SP2 = false>
__device__ __forceinline__ void gemm_phase(PG8_LAS unsigned char* lds, const Gemm g, const Sched& S, const Epi& E) {
    const int tid = threadIdx.x, wid = __builtin_amdgcn_readfirstlane(tid >> 6), lane = tid & 63, wr = wid >> 2, wc = wid & 3, fr = lane & 15, fq = lane >> 4;
    const int K = g.K, nt = K / BK;
    unsigned voffA[2], voffB[2];
#pragma unroll
    for (int i = 0; i < 2; ++i) { int R, C; stage_rc(tid * 16 + i * 8192, R, C); const int Rb = Epi::PERM ? ((R & ~31) + perm32(R & 31)) : R;
        voffA[i] = (unsigned)(R * K + C) * 2u; voffB[i] = (unsigned)(Rb * K + C) * 2u; }
    const size_t kstep = (size_t)(BK * 2);
    const size_t hstep = (size_t)HALF * K * 2;
    const size_t tstep = 2 * hstep;
    const unsigned ldsw = (unsigned)wid * 1024u;
    const int aoff = lds_byte(wr * 64 + fr, fq * 8), boff = lds_byte(wc * 32 + fr, fq * 8);
#define PG8_SA(b, h) (((b) * 2 + (h)) * HTB)
#define PG8_SB(b, h) ((4 + (b) * 2 + (h)) * HTB)
#define PG8_STAGE(bufoff, gbase, voff) do { _Pragma("unroll") for (int _i = 0; _i < 2; ++_i) \
        __builtin_amdgcn_global_load_lds((const unsigned*)((const char*)(gbase) + (voff)[_i]), (PG8_LAS unsigned*)(lds + (bufoff) + ldsw + _i * 8192), 16, 0, 0); } while (0)
#define PG8_LDA(dst, b, h) do { _Pragma("unroll") for (int m = 0; m < 4; ++m) _Pragma("unroll") for (int k = 0; k < 2; ++k) dst[m][k] = *(const PG8_LAS bf16x8*)(lds + PG8_SA(b, h) + aoff + m * 2048 + k * 1024); } while (0)
#define PG8_LDB(dst, b, h) do { _Pragma("unroll") for (int n = 0; n < 2; ++n) _Pragma("unroll") for (int k = 0; k < 2; ++k) dst[n][k] = *(const PG8_LAS bf16x8*)(lds + PG8_SB(b, h) + boff + n * 2048 + k * 1024); } while (0)
#define PG8_MMA(ai, bj, At, Bt) do { __builtin_amdgcn_s_setprio(1); _Pragma("unroll") for (int m = 0; m < 4; ++m) _Pragma("unroll") for (int n = 0; n < 2; ++n) _Pragma("unroll") for (int k = 0; k < 2; ++k) \
        acc[ai][bj][m][n] = __builtin_amdgcn_mfma_f32_16x16x32_bf16(Bt[n][k], At[m][k], acc[ai][bj][m][n], 0, 0, 0); __builtin_amdgcn_s_setprio(0); } while (0)
#define PG8_WAIT_V(n) asm volatile("s_waitcnt vmcnt(" #n ")" ::: "memory")
#define PG8_WAIT_L(n) asm volatile("s_waitcnt lgkmcnt(" #n ")" ::: "memory")
#define PG8_BAR __builtin_amdgcn_s_barrier()
#define PG8_SCHED __builtin_amdgcn_sched_barrier(0)
    Unit cur, nxt; int ui = 0;
    if (!S.next(0, cur)) return;
    f32x4 acc[2][2][4][2];
#pragma unroll
    for (int a = 0; a < 2; ++a)
#pragma unroll
        for (int b = 0; b < 2; ++b)
#pragma unroll
            for (int m = 0; m < 4; ++m)
#pragma unroll
                for (int n = 0; n < 2; ++n) acc[a][b][m][n] = (f32x4){0.f, 0.f, 0.f, 0.f};
    bf16x8 At[4][2], B0[2][2], B1[2][2];
    const char* cA = (const char*)g.A + (size_t)cur.pm * tstep; const char* cB = (const char*)g.Bt + (size_t)cur.pn * tstep;
    S.a_ready(cur);
    if constexpr (SP2) {
        PG8_STAGE(PG8_SB(0, 0), cB, voffB); PG8_STAGE(PG8_SB(0, 1), cB + hstep, voffB); PG8_STAGE(PG8_SA(0, 0), cA, voffA); PG8_STAGE(PG8_SA(0, 1), cA + hstep, voffA);
        if (wr == 1) PG8_BAR;
        PG8_WAIT_V(2); PG8_BAR;
        PG8_STAGE(PG8_SB(1, 0), cB + kstep, voffB); PG8_STAGE(PG8_SA(1, 0), cA + kstep, voffA); PG8_STAGE(PG8_SB(1, 1), cB + hstep + kstep, voffB);
        PG8_WAIT_V(6); PG8_BAR;
    } else {
        PG8_STAGE(PG8_SB(0, 0), cB, voffB); PG8_STAGE(PG8_SA(0, 0), cA, voffA); PG8_STAGE(PG8_SB(0, 1), cB + hstep, voffB); PG8_STAGE(PG8_SA(0, 1), cA + hstep, voffA);
        if (wr == 1) PG8_BAR;
        PG8_WAIT_V(4); PG8_BAR;
        PG8_STAGE(PG8_SB(1, 0), cB + kstep, voffB); PG8_STAGE(PG8_SA(1, 0), cA + kstep, voffA); PG8_STAGE(PG8_SB(1, 1), cB + hstep + kstep, voffB);
        PG8_WAIT_V(6); PG8_BAR;
    }
    for (;;) {
        const bool has_next = S.next(ui + 1, nxt);
        const char* nA = has_next ? (const char*)g.A + (size_t)nxt.pm * tstep : cA; const char* nB = has_next ? (const char*)g.Bt + (size_t)nxt.pn * tstep : cB;
        for (int t = 0; t < nt; t += 2) {
            const bool last = (t == nt - 2);
            const char* a1 = cA + (size_t)(t + 1) * kstep;
            const char* a2 = last ? nA : cA + (size_t)(t + 2) * kstep; const char* b2 = last ? nB : cB + (size_t)(t + 2) * kstep;
            const char* a3 = a2 + kstep; const char* b3 = b2 + kstep;
            if (last && has_next) S.a_ready(nxt);
            if constexpr (SP2) {
            PG8_LDB(B0, 0, 0); PG8_LDB(B1, 0, 1); PG8_SCHED; PG8_LDA(At, 0, 0); PG8_STAGE(PG8_SA(1, 1), a1 + hstep, voffA);
            PG8_WAIT_V(8); PG8_WAIT_L(0); PG8_BAR; PG8_MMA(0, 0, At, B0); PG8_MMA(0, 1, At, B1); PG8_BAR; PG8_SCHED;
            PG8_LDA(At, 0, 1); PG8_STAGE(PG8_SB(0, 0), b2, voffB); PG8_STAGE(PG8_SB(0, 1), b2 + hstep, voffB); PG8_STAGE(PG8_SA(0, 0), a2, voffA);
            PG8_WAIT_V(8); PG8_WAIT_L(0); PG8_BAR; PG8_MMA(1, 0, At, B0); PG8_MMA(1, 1, At, B1); PG8_BAR; PG8_SCHED;
            PG8_LDB(B0, 1, 0); PG8_LDB(B1, 1, 1); PG8_SCHED; PG8_LDA(At, 1, 0); PG8_STAGE(PG8_SA(0, 1), a2 + hstep, voffA);
            PG8_WAIT_V(8); PG8_WAIT_L(0); PG8_BAR; PG8_MMA(0, 0, At, B0); PG8_MMA(0, 1, At, B1); PG8_BAR; PG8_SCHED;
            PG8_LDA(At, 1, 1); PG8_STAGE(PG8_SB(1, 0), b3, voffB); PG8_STAGE(PG8_SB(1, 1), b3 + hstep, voffB); PG8_STAGE(PG8_SA(1, 0), a3, voffA);
            PG8_WAIT_V(8); PG8_WAIT_L(0); PG8_BAR; PG8_MMA(1, 0, At, B0); PG8_MMA(1, 1, At, B1); PG8_BAR; PG8_SCHED;
            } else {
            PG8_LDB(B0, 0, 0); PG8_SCHED; PG8_LDA(At, 0, 0); PG8_STAGE(PG8_SA(1, 1), a1 + hstep, voffA);
            PG8_WAIT_L(8); PG8_BAR; PG8_WAIT_L(0); PG8_MMA(0, 0, At, B0); PG8_BAR; PG8_SCHED;
            PG8_LDB(B1, 0, 1); PG8_STAGE(PG8_SB(0, 0), b2, voffB);
            PG8_BAR; PG8_WAIT_L(0); PG8_MMA(0, 1, At, B1); PG8_BAR;
            PG8_LDA(At, 0, 1); PG8_STAGE(PG8_SA(0, 0), a2, voffA);
            PG8_BAR; PG8_WAIT_L(0); PG8_MMA(1, 0, At, B0); PG8_BAR; PG8_SCHED;
            PG8_STAGE(PG8_SB(0, 1), b2 + hstep, voffB);
            PG8_WAIT_V(6); PG8_BAR; PG8_MMA(1, 1, At, B1); PG8_BAR;
            PG8_LDB(B0, 1, 0); PG8_SCHED; PG8_LDA(At, 1, 0); PG8_STAGE(PG8_SA(0, 1), a2 + hstep, voffA);
            PG8_WAIT_L(8); PG8_BAR; PG8_WAIT_L(0); PG8_MMA(0, 0, At, B0); PG8_BAR; PG8_SCHED;
            PG8_LDB(B1, 1, 1); PG8_STAGE(PG8_SB(1, 0), b3, voffB);
            PG8_BAR; PG8_WAIT_L(0); PG8_MMA(0, 1, At, B1); PG8_BAR;
            PG8_LDA(At, 1, 1); PG8_STAGE(PG8_SA(1, 0), a3, voffA);
            PG8_BAR; PG8_WAIT_L(0); PG8_MMA(1, 0, At, B0); PG8_BAR; PG8_SCHED;
            PG8_STAGE(PG8_SB(1, 1), b3 + hstep, voffB);
            PG8_WAIT_V(6); PG8_BAR; PG8_MMA(1, 1, At, B1); PG8_BAR;
            }
        }
        if constexpr (ALIGN_EPI) { if (wr == 0) PG8_BAR; }
        if constexpr (!Epi::AFTER_DRAIN) { E(acc, cur, wr, wc, fr, fq); S.done(cur); }
        if (!has_next) break;
#pragma unroll
        for (int a = 0; a < 2; ++a)
#pragma unroll
            for (int b = 0; b < 2; ++b)
#pragma unroll
                for (int m = 0; m < 4; ++m)
#pragma unroll
                    for (int n = 0; n < 2; ++n) acc[a][b][m][n] = (f32x4){0.f, 0.f, 0.f, 0.f};
        cur = nxt; cA = nA; cB = nB; ++ui;
        if constexpr (ALIGN_EPI) { if (wr == 1) PG8_BAR; }
    }
    PG8_WAIT_V(0);
    if constexpr (!ALIGN_EPI) { if (wr == 0) PG8_BAR; }
    PG8_BAR;
    if constexpr (Epi::AFTER_DRAIN) { E.fused(acc, cur, wr, wc, fr, fq, lds, wid, lane); S.done(cur); }
#undef PG8_SA
#undef PG8_SB
#undef PG8_STAGE
#undef PG8_LDA
#undef PG8_LDB
#undef PG8_MMA
#undef PG8_WAIT_V
#undef PG8_WAIT_L
#undef PG8_BAR
#undef PG8_SCHED
}
}

#define LAS __attribute__((address_space(3)))
typedef unsigned short bf16_t;
typedef short bf16x8 __attribute__((ext_vector_type(8)));
typedef short s16x4 __attribute__((ext_vector_type(4)));
typedef short v4i16_t __attribute__((ext_vector_type(4)));
typedef float f32x4 __attribute__((ext_vector_type(4)));
typedef float f32x2 __attribute__((ext_vector_type(2)));
typedef float f32x16 __attribute__((ext_vector_type(16)));
typedef unsigned u32x4 __attribute__((ext_vector_type(4)));
typedef unsigned u32x2 __attribute__((ext_vector_type(2)));
typedef __bf16 bf16x2_t __attribute__((ext_vector_type(2)));

constexpr int NTHREADS = 512, NWAVES = 8;
constexpr int DM = 1024, NPR = 8192, MROWS = 40960, KVROWS = 45056;
constexpr size_t MiB = 1u << 20;
constexpr size_t WS_W_EIN = 0, WS_W_EOUT = 8 * MiB, WS_W_OIN = 10 * MiB, WS_W_QUP = 14 * MiB, WS_W_KVUP = 16 * MiB, WS_W_OOUT = 17 * MiB;
constexpr size_t WS_MOD = 19 * MiB, WS_TAB = 19 * MiB + 512 * 1024, WS_BAR = 19 * MiB + 768 * 1024, WS_ACT = 20 * MiB, WS_P = 100 * MiB, WS_ST = 420 * MiB, WS_END = 500 * MiB;
constexpr size_t WS_QN = WS_ACT, WS_CKV = WS_ACT + 32 * MiB, WS_KR = WS_ACT + 56 * MiB;
constexpr size_t WS_LATQ = WS_P, WS_GATE = WS_P + 120 * MiB, WS_KV = WS_P + 200 * MiB, WS_LAT16 = WS_KV, WS_X2B = WS_KV;
constexpr size_t OFF_SF = 41943040, OFF_SB = OFF_SF + 2097152, OFF_CKV = OFF_SB + 2097152, OFF_KR = OFF_CKV + 2097152, OUT_TOTAL = OFF_KR + 524288;
constexpr int LDS_BYTES = 147456;
constexpr int PP = 3072;
constexpr float EPS = 1e-6f;

struct Params { const float* in[21]; float* out; unsigned char* ws; };
enum { I_XP = 0, I_XS, I_C, I_SRF, I_SRB, I_CCKV, I_CKR, I_CCTX, I_ADAW, I_ADAB, I_NORMG, I_EINW, I_CONVW, I_EOUTW, I_OINW, I_QNG, I_KVNG, I_QUPW, I_KVUPW, I_OOUTW, I_FING };

__device__ __forceinline__ unsigned cvtpk(float lo, float hi) { f32x2 v = {lo, hi}; bf16x2_t b = __builtin_convertvector(v, bf16x2_t); return __builtin_bit_cast(unsigned, b); }
__device__ __forceinline__ bf16_t f2bf(float x) { return (bf16_t)(cvtpk(x, 0.f) & 0xffffu); }
__device__ __forceinline__ float bflo(unsigned w) { return __uint_as_float(w << 16); }
__device__ __forceinline__ float bfhi(unsigned w) { return __uint_as_float(w & 0xffff0000u); }
__device__ __forceinline__ float silu_f(float v) { return v / (1.f + __expf(-v)); }
__device__ __forceinline__ float wave_sum(float v) {
#pragma unroll
    for (int o = 1; o < 64; o <<= 1) v += __shfl_xor(v, o);
    return v;
}
__device__ __forceinline__ int crow(int r, int hi) { return (r & 3) + 8 * (r >> 2) + 4 * hi; }
__device__ __forceinline__ unsigned off_b(unsigned row, unsigned ch) { return 256u * row + 16u * (ch ^ (((row & 3) << 2) | ((row >> 2) & 3))); }
__device__ __forceinline__ s16x4 vtr(LAS const char* p) { return __builtin_bit_cast(s16x4, __builtin_amdgcn_ds_read_tr16_b64_v4i16((LAS v4i16_t*)p)); }
__device__ __forceinline__ bf16x8 mk8(s16x4 lo, s16x4 hi) { return __builtin_shufflevector(lo, hi, 0, 1, 2, 3, 4, 5, 6, 7); }
#define MFMA32(a, b, c) __builtin_amdgcn_mfma_f32_32x32x16_bf16((a), (b), (c), 0, 0, 0)

namespace pg8 {
struct EpiBf16S {
    static constexpr bool PERM = true, AFTER_DRAIN = false;
    bf16_t* O; int ldc; int s_lo, s_hi; float sc; int o2_from; bf16_t* O2; int ldc2;
    int pair_from;
    int pair_col0;
    __device__ __forceinline__ void operator()(const f32x4 (&acc)[2][2][4][2], const Unit& u, int wr, int wc, int fr, int fq) const {
        const int row0 = u.pm * BM + wr * 64 + fr;
        if (u.pn >= pair_from) {
            const bool gated = u.pn >= pair_from + 4;
            const int col0 = pair_col0 + (u.pn - pair_from) * (BM / 2) + wc * 16 + 4 * fq;
#pragma unroll
            for (int ai = 0; ai < 2; ++ai)
#pragma unroll
                for (int m = 0; m < 4; ++m) { bf16_t* rowp = O + (size_t)(row0 + ai * HALF + m * 16) * ldc + col0;
#pragma unroll
                    for (int bj = 0; bj < 2; ++bj) { const f32x4 a0 = acc[ai][bj][m][0]; f32x4 a1 = acc[ai][bj][m][1];
                        if (gated) { a1[0] = a1[0] / (1.f + __expf(-a1[0])); a1[1] = a1[1] / (1.f + __expf(-a1[1])); a1[2] = a1[2] / (1.f + __expf(-a1[2])); a1[3] = a1[3] / (1.f + __expf(-a1[3])); }
                        const f32x4 v = a0 * a1; u32x2 w; w.x = ::cvtpk(v[0], v[1]); w.y = ::cvtpk(v[2], v[3]);
                        *(u32x2*)(rowp + bj * (HALF / 2)) = w; } }
            return;
        }
        const bool second = u.pn >= o2_from;
        bf16_t* base = second ? O2 : O; const int ld = second ? ldc2 : ldc;
        const float s = (u.pn >= s_lo && u.pn < s_hi) ? sc : 1.f;
        const int col0 = (second ? u.pn - o2_from : u.pn) * BM + wc * 32 + 8 * fq;
#pragma unroll
        for (int ai = 0; ai < 2; ++ai)
#pragma unroll
            for (int m = 0; m < 4; ++m) { bf16_t* rowp = base + (size_t)(row0 + ai * HALF + m * 16) * ld + col0;
#pragma unroll
                for (int bj = 0; bj < 2; ++bj) { const f32x4 v0 = acc[ai][bj][m][0] * s, v1 = acc[ai][bj][m][1] * s;
                    u32x4 w; w.x = ::cvtpk(v0[0], v0[1]); w.y = ::cvtpk(v0[2], v0[3]); w.z = ::cvtpk(v1[0], v1[1]); w.w = ::cvtpk(v1[2], v1[3]);
                    *(u32x4*)(rowp + bj * HALF) = w; } }
    }
};
struct EpiRes {
    static constexpr bool PERM = false, AFTER_DRAIN = false;
    const float* xp; const float* xs; const bf16_t* B16; bf16_t* O16; const float* modl; int pm0;
    __device__ __forceinline__ void operator()(const f32x4 (&acc)[2][2][4][2], const Unit& u, int wr, int wc, int fr, int fq) const {
        const int pma = u.pm + pm0; const int r = pma < 32 ? 8 : ((pma - 32) >> 4);
        const float* gate = modl + r * 3072 + 2048;
        const int col0 = u.pn * BM + wc * 32 + 4 * fq;
        f32x4 gv[2][2];
#pragma unroll
        for (int bj = 0; bj < 2; ++bj)
#pragma unroll
            for (int n = 0; n < 2; ++n) gv[bj][n] = *(const f32x4*)(gate + col0 + bj * HALF + n * 16);
#pragma unroll
        for (int ai = 0; ai < 2; ++ai)
#pragma unroll
            for (int m = 0; m < 4; ++m) { const int row = pma * BM + ai * HALF + wr * 64 + m * 16 + fr;
                const float* xr = (row < 8192) ? xp + (size_t)row * 1024 : xs + (size_t)(row - 8192) * 1024;
#pragma unroll
                for (int bj = 0; bj < 2; ++bj)
#pragma unroll
                    for (int n = 0; n < 2; ++n) { const int c = col0 + bj * HALF + n * 16; f32x4 xv;
                        if (B16) { const u32x2 w = *(const u32x2*)(B16 + (size_t)row * 1024 + c); xv = (f32x4){::bflo(w.x), ::bfhi(w.x), ::bflo(w.y), ::bfhi(w.y)}; }
                        else xv = __builtin_nontemporal_load((const f32x4*)(xr + c));
                        const f32x4 o = xv + gv[bj][n] * acc[ai][bj][m][n];
                        u32x2 w2; w2.x = ::cvtpk(o[0], o[1]); w2.y = ::cvtpk(o[2], o[3]); *(u32x2*)(O16 + (size_t)row * 1024 + c) = w2; } }
    }
};
struct EpiQ {
    static constexpr bool PERM = false, AFTER_DRAIN = false;
    bf16_t* O; const f32x2* tab;
    __device__ __forceinline__ void operator()(const f32x4 (&acc)[2][2][4][2], const Unit& u, int wr, int wc, int fr, int fq) const {
        const bool rope = u.pm >= 32;
        const int col0 = u.pn * BM + wc * 32 + 4 * fq;
#pragma unroll
        for (int ai = 0; ai < 2; ++ai)
#pragma unroll
            for (int m = 0; m < 4; ++m) { const int row = u.pm * BM + ai * HALF + wr * 64 + m * 16 + fr; const int t = (row - 8192) & 4095;
                bf16_t* rowp = O + (size_t)row * 1536 + col0;
#pragma unroll
                for (int bj = 0; bj < 2; ++bj) { f32x4 v0 = acc[ai][bj][m][0], v1 = acc[ai][bj][m][1];
                    const int g = 8 * u.pn + 4 * bj + wc, gh = g % 6;
                    if (rope && gh >= 4) { const int pos = (gh == 4) ? (t >> 6) : (t & 63); const f32x2* tp = tab + pos * 16 + 4 * fq;
#pragma unroll
                        for (int e = 0; e < 4; ++e) { const f32x2 cs = tp[e]; const float x1 = v0[e], x2 = v1[e]; v0[e] = x1 * cs.x - x2 * cs.y; v1[e] = x1 * cs.y + x2 * cs.x; } }
                    u32x2 w0, w1; w0.x = ::cvtpk(v0[0], v0[1]); w0.y = ::cvtpk(v0[2], v0[3]); w1.x = ::cvtpk(v1[0], v1[1]); w1.y = ::cvtpk(v1[2], v1[3]);
                    *(u32x2*)(rowp + bj * HALF) = w0; *(u32x2*)(rowp + bj * HALF + 16) = w1; }
                asm volatile("" ::: "memory"); }
    }
};
}

__device__ __forceinline__ int ein_row(int n) {
    if (n < 2048) return n;
    const int sec = (n - 2048) >> 9, ch = (n - 2048) & 511, g8 = 8 * (ch >> 2) + (ch & 3);
    return sec == 0 ? 3072 + g8 : sec == 1 ? 2048 + g8 : sec == 2 ? 2048 + g8 + 4 : 3072 + g8 + 4;
}
__device__ __forceinline__ void transpose_item(const float* __restrict__ W, int K, int N, bf16_t* WT, int k0, int n0, int drow0, LAS float* scr, int lane, int kind = 0) {
#pragma unroll 8
    for (int i = 0; i < 32; ++i) { const int kk = 2 * i + (lane >> 5); scr[kk * 33 + (lane & 31)] = __builtin_nontemporal_load(W + (size_t)(k0 + kk) * N + n0 + (lane & 31)); }
    asm volatile("s_waitcnt lgkmcnt(0)" ::: "memory");
    const int c = lane & 7;
#pragma unroll
    for (int j = 0; j < 4; ++j) { const int n = (lane >> 3) + 8 * j; const LAS float* s = scr + (8 * c) * 33 + n;
        u32x4 o; o.x = cvtpk(s[0 * 33], s[1 * 33]); o.y = cvtpk(s[2 * 33], s[3 * 33]); o.z = cvtpk(s[4 * 33], s[5 * 33]); o.w = cvtpk(s[6 * 33], s[7 * 33]);
        *(u32x4*)(WT + (size_t)(kind ? ein_row(n0 + n) : drow0 + n) * K + k0 + 8 * c) = o; }
    asm volatile("s_waitcnt lgkmcnt(0)" ::: "memory");
}

__device__ __forceinline__ void p0_phase(const Params& p, LAS char* L, int G) {
    const int tid = threadIdx.x, lane = tid & 63, wave = tid >> 6;
    unsigned char* ws = p.ws;
    float* mod = (float*)(ws + WS_MOD);
    if ((int)blockIdx.x < 192) {
        LAS float* sil = (LAS float*)L; LAS float* red = (LAS float*)(L + 36864);
        for (int i = tid; i < 9216; i += NTHREADS) { const int r = i >> 10, k = i & 1023; const float v = r < 8 ? p.in[I_C][r * 1024 + k] : p.in[I_CCTX][k]; sil[i] = v / (1.f + expf(-v)); }
        __syncthreads();
        for (int it = blockIdx.x; it < 192; it += G) {
            const int l = it / 96, n0 = (it % 96) * 32, col = lane & 31, ksub = lane >> 5;
            const float* Wl = p.in[I_ADAW] + (size_t)l * 1024 * 3072 + n0 + col;
            float a[9];
#pragma unroll
            for (int r = 0; r < 9; ++r) a[r] = 0.f;
#pragma unroll 8
            for (int i = 0; i < 64; ++i) { const int k = 128 * wave + 2 * i + ksub; const float w = __builtin_nontemporal_load(Wl + (size_t)k * 3072);
#pragma unroll
                for (int r = 0; r < 9; ++r) a[r] += sil[r * 1024 + k] * w; }
#pragma unroll
            for (int r = 0; r < 9; ++r) { a[r] += __shfl_xor(a[r], 32); if (ksub == 0) red[(wave * 9 + r) * 32 + col] = a[r]; }
            __syncthreads();
            if (tid < 288) { const int r = tid >> 5, cc = tid & 31; float s = p.in[I_ADAB][l * 3072 + n0 + cc];
#pragma unroll
                for (int w = 0; w < 8; ++w) s += red[(w * 9 + r) * 32 + cc];
                mod[(size_t)(l * 9 + r) * 3072 + n0 + cc] = s; }
            __syncthreads();
        }
    }
    { const int gt = blockIdx.x * NTHREADS + tid;
      if (gt < 1024) { const int pos = gt >> 4, fi = gt & 15; const float inv = exp2f(-(float)fi * (13.287712379549449f / 16.f)); const float ang = (float)pos * inv;
          float rev = ang * 0.15915494309189535f; rev -= floorf(rev);
          ((f32x2*)(ws + WS_TAB))[gt] = (f32x2){__builtin_amdgcn_cosf(rev), __builtin_amdgcn_sinf(rev)}; } }
    { const int gt = blockIdx.x * NTHREADS + tid; u32x4* z = (u32x4*)(ws + WS_W_OIN + (size_t)1728 * 1024 * 2);
      for (int i = gt; i < 64 * 1024 * 2 / 16; i += G * NTHREADS) z[i] = (u32x4){0u, 0u, 0u, 0u}; }
    LAS float* scr = (LAS float*)(L + 49152 + wave * 8448);
    const int gw = blockIdx.x * NWAVES + wave, NGW = G * NWAVES;
    constexpr int I0 = 16 * 128, I1 = 16 * 32, I2 = 16 * 54, I3 = 6 * 48, I4 = 4 * 64, I5 = 16 * 32, NIT = I0 + I1 + I2 + I3 + I4 + I5;
    for (int it = gw; it < NIT; it += NGW) {
        int r = it;
        if (r < I0) { const int nb = r % 128, kb = r / 128; transpose_item(p.in[I_EINW], 1024, 4096, (bf16_t*)(ws + WS_W_EIN), kb * 64, nb * 32, nb * 32, scr, lane, 1); continue; } r -= I0;
        if (r < I1) { const int nb = r % 32, kb = r / 32; transpose_item(p.in[I_EOUTW], 1024, 1024, (bf16_t*)(ws + WS_W_EOUT), kb * 64, nb * 32, nb * 32, scr, lane); continue; } r -= I1;
        if (r < I2) { const int nb = r % 54, kb = r / 54, n0 = nb * 32; const int d0 = n0 < 704 ? n0 + 1024 : n0 - 704;
            transpose_item(p.in[I_OINW], 1024, 1728, (bf16_t*)(ws + WS_W_OIN), kb * 64, n0, d0, scr, lane); continue; } r -= I2;
        if (r < I3) { const int nb = r % 48, kb = r / 48; transpose_item(p.in[I_QUPW], 384, 1536, (bf16_t*)(ws + WS_W_QUP), kb * 64, nb * 32, nb * 32, scr, lane); continue; } r -= I3;
        if (r < I4) { const int nb = r % 64, kb = r / 64; transpose_item(p.in[I_KVUPW], 256, 2048, (bf16_t*)(ws + WS_W_KVUP), kb * 64, nb * 32, nb * 32, scr, lane); continue; } r -= I4;
        { const int nb = r % 32, kb = r / 32; transpose_item(p.in[I_OOUTW], 1024, 1024, (bf16_t*)(ws + WS_W_OOUT), kb * 64, nb * 32, nb * 32, scr, lane); }
    }
}

__device__ __forceinline__ f32x4 ld_row4(const float* xf, const bf16_t* x16, size_t off) {
    if (x16) { const u32x2 w = *(const u32x2*)(x16 + off); return (f32x4){bflo(w.x), bfhi(w.x), bflo(w.y), bfhi(w.y)}; }
    return __builtin_nontemporal_load((const f32x4*)(xf + off));
}
__device__ __forceinline__ void norm_mod_phase(const float* xp, const float* xs, const bf16_t* x16, const float* g, const float* modl, bf16_t* H, int gwb, int nwb, int lo0, int hi0, int lo1, int hi1) {
    const int lane = threadIdx.x & 63, wave = threadIdx.x >> 6;
    const int gw = gwb * NWAVES + wave, NGW = nwb * NWAVES, n0_ = hi0 - lo0, total = n0_ + (hi1 - lo1);
    f32x4 gv[4];
#pragma unroll
    for (int j = 0; j < 4; ++j) gv[j] = *(const f32x4*)(g + 4 * lane + 256 * j);
    for (int i0 = gw; i0 < total; i0 += 2 * NGW) {
        const bool has1 = i0 + NGW < total; const int i1 = has1 ? i0 + NGW : i0;
        const int m0 = i0 < n0_ ? lo0 + i0 : lo1 + (i0 - n0_), m1 = i1 < n0_ ? lo0 + i1 : lo1 + (i1 - n0_);
        const float* xf0 = x16 ? nullptr : ((m0 < NPR) ? xp + (size_t)m0 * DM : xs + (size_t)(m0 - NPR) * DM);
        const float* xf1 = x16 ? nullptr : ((m1 < NPR) ? xp + (size_t)m1 * DM : xs + (size_t)(m1 - NPR) * DM);
        const bf16_t* xb0 = x16 ? x16 + (size_t)m0 * DM : nullptr; const bf16_t* xb1 = x16 ? x16 + (size_t)m1 * DM : nullptr;
        const float* md0 = modl + ((m0 < NPR) ? 8 : ((m0 - NPR) >> 12)) * 3072; const float* md1 = modl + ((m1 < NPR) ? 8 : ((m1 - NPR) >> 12)) * 3072;
        f32x4 v0[4], v1[4], sc0[4], sh0[4], sc1[4], sh1[4];
#pragma unroll
        for (int j = 0; j < 4; ++j) { const int c = 4 * lane + 256 * j; v0[j] = ld_row4(xf0, xb0, c); v1[j] = ld_row4(xf1, xb1, c); }
#pragma unroll
        for (int j = 0; j < 4; ++j) { const int c = 4 * lane + 256 * j; sh0[j] = *(const f32x4*)(md0 + c); sc0[j] = *(const f32x4*)(md0 + 1024 + c); sh1[j] = *(const f32x4*)(md1 + c); sc1[j] = *(const f32x4*)(md1 + 1024 + c); }
        float s0 = 0.f, s1 = 0.f;
#pragma unroll
        for (int j = 0; j < 4; ++j) { s0 += (v0[j].x * v0[j].x + v0[j].y * v0[j].y) + (v0[j].z * v0[j].z + v0[j].w * v0[j].w); s1 += (v1[j].x * v1[j].x + v1[j].y * v1[j].y) + (v1[j].z * v1[j].z + v1[j].w * v1[j].w); }
#pragma unroll
        for (int o = 1; o < 64; o <<= 1) { s0 += __shfl_xor(s0, o); s1 += __shfl_xor(s1, o); }
        const float r0 = rsqrtf(s0 * (1.f / DM) + EPS), r1 = rsqrtf(s1 * (1.f / DM) + EPS);
#pragma unroll
        for (int j = 0; j < 4; ++j) { const int c = 4 * lane + 256 * j;
            { const f32x4 h = (v0[j] * r0) * gv[j] * (sc0[j] + 1.f) + sh0[j]; u32x2 w; w.x = cvtpk(h.x, h.y); w.y = cvtpk(h.z, h.w); *(u32x2*)(H + (size_t)m0 * DM + c) = w; }
            if (has1) { const f32x4 h = (v1[j] * r1) * gv[j] * (sc1[j] + 1.f) + sh1[j]; u32x2 w; w.x = cvtpk(h.x, h.y); w.y = cvtpk(h.z, h.w); *(u32x2*)(H + (size_t)m1 * DM + c) = w; } }
    }
}

__device__ __forceinline__ void ret_local_phase(const Params& p, LAS char* L, int G) {
    const int tid = threadIdx.x, lane = tid & 63, wave = tid >> 6, h5 = lane >> 5, l31 = lane & 31, dir = wave >> 2, eb = wave & 3;
    const int blk = (lane >> 4) & 1, q = (lane & 15) >> 2, pp = lane & 3;
    const bf16_t* P = (const bf16_t*)(p.ws + WS_P); bf16_t* ST = (bf16_t*)(p.ws + WS_ST);
    LAS char* Vt = L; LAS char* Kt = L + 32768 + dir * 32768;
    const unsigned r0 = 8 * h5 + q, r1 = r0 + 4;
    const unsigned aA0 = off_b(r0, 4 * eb + 2 * blk + (pp >> 1)) + 8 * (pp & 1), aA1 = off_b(r1, 4 * eb + 2 * blk + (pp >> 1)) + 8 * (pp & 1);
    const int njobs = 1024 + 256;
    for (int u = blockIdx.x; u < 1024 + 128; u += G) {
        const bool ctx = u >= 1024; const int v_ = u & 255; const int hh = ctx ? (u & 3) : ((v_ >> 3) & 3);
        const float lgf = log2f(1.f - exp2f(-5.f - (float)hh)), lgb = log2f(1.f - exp2f(-5.5f - (float)hh));
        const float cdec = exp2f(128.f * (dir ? lgb : lgf));
        const int seq = (u - 1024) >> 2;
#pragma unroll 1
        for (int j = 0; j < (ctx ? 2 : 1); ++j) {
            const int gc = ctx ? 2 * seq + j : 64 + (u >> 8) * 64 + (v_ & 7) + 8 * (v_ >> 5);
            const size_t rowbase = (size_t)gc * 128;
            __syncthreads();
#pragma unroll
            for (int i = 0; i < 4; ++i) { const int n = tid + 512 * i, row = n >> 4, ch = n & 15; const bf16_t* gp = P + (rowbase + row) * PP + hh * 128 + ch * 8;
                const u32x4 w = *(const u32x4*)(gp + 512), v = *(const u32x4*)(gp + 1024); const unsigned o = off_b(row, ch);
                const float kf = exp2f(lgf * (float)(127 - row)), kb = exp2f(lgb * (float)row);
                u32x4 a, b;
                a.x = cvtpk(bflo(w.x) * kf, bfhi(w.x) * kf); a.y = cvtpk(bflo(w.y) * kf, bfhi(w.y) * kf); a.z = cvtpk(bflo(w.z) * kf, bfhi(w.z) * kf); a.w = cvtpk(bflo(w.w) * kf, bfhi(w.w) * kf);
                b.x = cvtpk(bflo(w.x) * kb, bfhi(w.x) * kb); b.y = cvtpk(bflo(w.y) * kb, bfhi(w.y) * kb); b.z = cvtpk(bflo(w.z) * kb, bfhi(w.z) * kb); b.w = cvtpk(bflo(w.w) * kb, bfhi(w.w) * kb);
                *(LAS u32x4*)(Vt + o) = v; *(LAS u32x4*)(L + 32768 + o) = a; *(LAS u32x4*)(L + 65536 + o) = b; }
            __syncthreads();
            f32x16 acc[4];
#pragma unroll
            for (int x = 0; x < 4; ++x)
#pragma unroll
                for (int r = 0; r < 16; ++r) acc[x][r] = 0.f;
#pragma unroll 2
            for (int ks = 0; ks < 8; ++ks) {
                const bf16x8 A = mk8(vtr(Vt + aA0 + 4096 * ks), vtr(Vt + aA1 + 4096 * ks));
#pragma unroll
                for (int x = 0; x < 4; ++x) { const unsigned cb = 4 * x + 2 * blk + (pp >> 1);
                    const bf16x8 B = mk8(vtr(Kt + off_b(r0, cb) + 8 * (pp & 1) + 4096 * ks), vtr(Kt + off_b(r1, cb) + 8 * (pp & 1) + 4096 * ks));
                    acc[x] = MFMA32(A, B, acc[x]); }
            }
            bf16_t* own = ST + ((size_t)(gc * 4 + hh) * 2 + dir) * 16384;
            if (!ctx) {
#pragma unroll
                for (int x = 0; x < 4; ++x)
#pragma unroll
                    for (int r = 0; r < 16; ++r) own[(32 * eb + crow(r, h5)) * 128 + 32 * x + l31] = f2bf(acc[x][r]);
            } else {
                const bool first_in_dir = (dir == 0) ? (j == 0) : (j == 1);
                bf16_t* other = ST + ((size_t)((gc ^ 1) * 4 + hh) * 2 + dir) * 16384;
                if (first_in_dir) {
#pragma unroll
                    for (int x = 0; x < 4; ++x)
#pragma unroll
                        for (int r = 0; r < 16; ++r) { const int o = (32 * eb + crow(r, h5)) * 128 + 32 * x + l31; own[o] = 0; other[o] = f2bf(acc[x][r]); }
                }
                float* dst = p.out + (dir ? OFF_SB : OFF_SF) + (size_t)(seq * 4 + hh) * 16384;
                const float sc = first_in_dir ? cdec : 1.f;
#pragma unroll
                for (int x = 0; x < 4; ++x) { const int d = 32 * x + l31;
#pragma unroll
                    for (int rg = 0; rg < 4; ++rg) { float* dp = dst + d * 128 + 32 * eb + 8 * rg + 4 * h5;
                        f32x4 v = (f32x4){acc[x][4 * rg], acc[x][4 * rg + 1], acc[x][4 * rg + 2], acc[x][4 * rg + 3]} * sc;
                        if (j == 1) v += *(const f32x4*)dp;
                        *(f32x4*)dp = v; } }
            }
        }
    }
}
__device__ __forceinline__ void ret_scan2_phase(const Params& p, int G) {
    bf16_t* ST = (bf16_t*)(p.ws + WS_ST);
    for (int it = blockIdx.x * NTHREADS + threadIdx.x; it < 64 * 2048; it += G * NTHREADS) {
        const int chain = it >> 11, b = chain >> 3, hh = (chain >> 1) & 3, dir = chain & 1, e = (it >> 4) & 127, d0 = (it & 15) * 8;
        const float lg = log2f(1.f - exp2f(-5.f - (float)hh - 0.5f * (float)dir)), cdec = exp2f(128.f * lg);
        const float* src = p.in[dir ? I_SRB : I_SRF] + (size_t)(b * 4 + hh) * 16384;
        float S[8];
#pragma unroll
        for (int i = 0; i < 8; ++i) S[i] = src[(d0 + i) * 128 + e];
        bf16_t* base = ST + ((size_t)((64 + b * 32) * 4 + hh) * 2 + dir) * 16384 + e * 128 + d0;
#pragma unroll 1
        for (int kb = 0; kb < 2; ++kb) {
            u32x4 Lr[16];
#pragma unroll
            for (int i = 0; i < 16; ++i) { const int c = dir ? 31 - (kb * 16 + i) : kb * 16 + i; Lr[i] = *(const u32x4*)(base + (size_t)c * 8 * 16384); }
#pragma unroll
            for (int i = 0; i < 16; ++i) { const int c = dir ? 31 - (kb * 16 + i) : kb * 16 + i;
                u32x4 o; o.x = cvtpk(S[0], S[1]); o.y = cvtpk(S[2], S[3]); o.z = cvtpk(S[4], S[5]); o.w = cvtpk(S[6], S[7]);
                *(u32x4*)(base + (size_t)c * 8 * 16384) = o;
                const u32x4 w = Lr[i];
                S[0] = S[0] * cdec + bflo(w.x); S[1] = S[1] * cdec + bfhi(w.x); S[2] = S[2] * cdec + bflo(w.y); S[3] = S[3] * cdec + bfhi(w.y);
                S[4] = S[4] * cdec + bflo(w.z); S[5] = S[5] * cdec + bfhi(w.z); S[6] = S[6] * cdec + bflo(w.w); S[7] = S[7] * cdec + bfhi(w.w); }
        }
    }
}

__device__ __forceinline__ void ret_out_phase(const Params& p, LAS char* L, int G) {
    const int tid = threadIdx.x, lane = tid & 63, wave = tid >> 6, h5 = lane >> 5, blk = (lane >> 4) & 1, q = (lane & 15) >> 2, pp = lane & 3, l31 = lane & 31;
    LAS char* Qt = L; LAS char* Kt = L + 32768; LAS char* Vt = L + 65536; LAS float* ssq = (LAS float*)(L + 98304);
    const bf16_t* P = (const bf16_t*)(p.ws + WS_P); const bf16_t* ST = (const bf16_t*)(p.ws + WS_ST); bf16_t* MIX = (bf16_t*)(p.ws + WS_ACT);
    const float* convw = p.in[I_CONVW];
    const int ib = wave & 3, eh = wave >> 2;
    for (int u = blockIdx.x; u < 1280; u += G) {
        const int v_ = u & 255, hh = (v_ >> 3) & 3, gc = (u >> 8) * 64 + (v_ & 7) + 8 * (v_ >> 5);
        const size_t rowbase = (size_t)gc * 128;
        const int T = gc < 64 ? 256 : 4096, tok0 = gc < 64 ? (gc & 1) * 128 : ((gc - 64) & 31) * 128;
        const float lgf = log2f(1.f - exp2f(-5.f - (float)hh)), lgb = log2f(1.f - exp2f(-5.5f - (float)hh));
        const int i_tok = 32 * ib + l31;
        const bf16_t* stf = ST + ((size_t)gc * 4 + hh) * 2 * 16384; const bf16_t* stb = stf + 16384;
        u32x4 tq[4], tf[4], tb[4], tk[4], tv[4], tg[4];
#pragma unroll
        for (int i = 0; i < 4; ++i) { const int n = tid + 512 * i, row = n >> 4, ch = n & 15; const bf16_t* gp = P + (rowbase + row) * PP + hh * 128 + ch * 8;
            tq[i] = *(const u32x4*)gp; tf[i] = *(const u32x4*)(stf + row * 128 + ch * 8); tb[i] = *(const u32x4*)(stb + row * 128 + ch * 8); }
#pragma unroll
        for (int i = 0; i < 4; ++i) { const int n = tid + 512 * i, row = n >> 4, ch = n & 15; const bf16_t* gp = P + (rowbase + row) * PP + hh * 128 + ch * 8;
            tk[i] = *(const u32x4*)(gp + 512); tv[i] = *(const u32x4*)(gp + 1024); tg[i] = *(const u32x4*)(gp + 1536); }
        __syncthreads();
#pragma unroll
        for (int i = 0; i < 4; ++i) { const int n = tid + 512 * i, row = n >> 4, ch = n & 15; const unsigned o = off_b(row, ch);
            *(LAS u32x4*)(Qt + o) = tq[i]; *(LAS u32x4*)(Kt + o) = tf[i]; *(LAS u32x4*)(Vt + o) = tb[i]; }
        __syncthreads();
        f32x16 o[2];
        {
            f32x16 aF[2], aB[2];
#pragma unroll
            for (int x = 0; x < 2; ++x)
#pragma unroll
                for (int r = 0; r < 16; ++r) { aF[x][r] = 0.f; aB[x][r] = 0.f; }
            __builtin_amdgcn_s_setprio(1);
#pragma unroll
            for (int s = 0; s < 8; ++s) {
                const bf16x8 qf = *(const LAS bf16x8*)(Qt + off_b(i_tok, 2 * s + h5));
#pragma unroll
                for (int x = 0; x < 2; ++x) { const unsigned er = 32 * (2 * eh + x) + l31;
                    const bf16x8 af = *(const LAS bf16x8*)(Kt + off_b(er, 2 * s + h5)), ab = *(const LAS bf16x8*)(Vt + off_b(er, 2 * s + h5));
                    aF[x] = MFMA32(af, qf, aF[x]); aB[x] = MFMA32(ab, qf, aB[x]); }
            }
            __builtin_amdgcn_s_setprio(0);
            const float qdf = exp2f(lgf * (float)(i_tok + 1)), qdb = exp2f(lgb * (float)(128 - i_tok));
#pragma unroll
            for (int x = 0; x < 2; ++x)
#pragma unroll
                for (int r = 0; r < 16; ++r) o[x][r] = qdf * aF[x][r] + qdb * aB[x][r];
        }
        __syncthreads();
#pragma unroll
        for (int i = 0; i < 4; ++i) { const int n = tid + 512 * i, row = n >> 4, ch = n & 15; const unsigned oo = off_b(row, ch);
            *(LAS u32x4*)(Kt + oo) = tk[i]; *(LAS u32x4*)(Vt + oo) = tv[i]; }
        __syncthreads();
        __builtin_amdgcn_s_setprio(1);
#pragma unroll 1
        for (int jb = 0; jb < 4; ++jb) {
            f32x16 pacc;
#pragma unroll
            for (int r = 0; r < 16; ++r) pacc[r] = 0.f;
#pragma unroll
            for (int s = 0; s < 8; ++s) {
                const bf16x8 kf = *(const LAS bf16x8*)(Kt + off_b(32 * jb + l31, 2 * s + h5));
                const bf16x8 qf = *(const LAS bf16x8*)(Qt + off_b(i_tok, 2 * s + h5));
                pacc = MFMA32(kf, qf, pacc);
            }
#pragma unroll
            for (int r = 0; r < 16; ++r) { const int j = 32 * jb + crow(r, h5); const int dij = i_tok - j;
                const float mval = dij > 0 ? exp2f(lgf * (float)dij) : (dij < 0 ? exp2f(lgb * (float)(-dij)) : 2.f);
                pacc[r] *= mval; }
#pragma unroll
            for (int s2 = 0; s2 < 2; ++s2) {
                u32x4 w; w.x = cvtpk(pacc[8 * s2], pacc[8 * s2 + 1]); w.y = cvtpk(pacc[8 * s2 + 2], pacc[8 * s2 + 3]); w.z = cvtpk(pacc[8 * s2 + 4], pacc[8 * s2 + 5]); w.w = cvtpk(pacc[8 * s2 + 6], pacc[8 * s2 + 7]);
                const bf16x8 xs = __builtin_bit_cast(bf16x8, w);
                const unsigned r0 = 32 * jb + 16 * s2 + 4 * h5 + q, r1 = r0 + 8;
#pragma unroll
                for (int x = 0; x < 2; ++x) { const unsigned cb = 4 * (2 * eh + x) + 2 * blk + (pp >> 1);
                    const bf16x8 vf = mk8(vtr(Vt + off_b(r0, cb) + 8 * (pp & 1)), vtr(Vt + off_b(r1, cb) + 8 * (pp & 1)));
                    o[x] = MFMA32(vf, xs, o[x]); }
            }
        }
        __builtin_amdgcn_s_setprio(0);
        float ss = 0.f;
#pragma unroll
        for (int x = 0; x < 2; ++x)
#pragma unroll
            for (int r = 0; r < 16; ++r) ss += o[x][r] * o[x][r];
        ss += __shfl_xor(ss, 32);
        if (h5 == 0) ssq[wave * 32 + l31] = ss;
        __syncthreads();
        ss += ssq[(wave ^ 4) * 32 + l31];
        const float rstd = rsqrtf(ss * (1.f / 128.f) + EPS);
#pragma unroll
        for (int x = 0; x < 2; ++x)
#pragma unroll
            for (int rg = 0; rg < 4; ++rg) { const int e0 = 32 * (2 * eh + x) + 8 * rg + 4 * h5;
                u32x2 w; w.x = cvtpk(o[x][4 * rg] * rstd, o[x][4 * rg + 1] * rstd); w.y = cvtpk(o[x][4 * rg + 2] * rstd, o[x][4 * rg + 3] * rstd);
                *(LAS u32x2*)(Qt + off_b(i_tok, e0 >> 3) + 2 * (e0 & 7)) = w; }
        __syncthreads();
#pragma unroll
        for (int i = 0; i < 4; ++i) { const int n = tid + 512 * i, row = n >> 4, ch = n & 15;
            const u32x4 ov = *(const LAS u32x4*)(Qt + off_b(row, ch)); const u32x4 g = tg[i]; u32x4 w;
            w.x = cvtpk(bflo(ov.x) * silu_f(bflo(g.x)), bfhi(ov.x) * silu_f(bfhi(g.x))); w.y = cvtpk(bflo(ov.y) * silu_f(bflo(g.y)), bfhi(ov.y) * silu_f(bfhi(g.y)));
            w.z = cvtpk(bflo(ov.z) * silu_f(bflo(g.z)), bfhi(ov.z) * silu_f(bfhi(g.z))); w.w = cvtpk(bflo(ov.w) * silu_f(bflo(g.w)), bfhi(ov.w) * silu_f(bfhi(g.w)));
            *(u32x4*)(MIX + (rowbase + row) * 1024 + hh * 128 + ch * 8) = w; }
        { const int c8 = (tid & 15) * 8, tr = tid >> 4, cc = hh * 128 + c8;
          float w0[8], w1[8], w2[8];
#pragma unroll
          for (int e_ = 0; e_ < 8; ++e_) { w0[e_] = convw[cc + e_]; w1[e_] = convw[512 + cc + e_]; w2[e_] = convw[1024 + cc + e_]; }
#pragma unroll 2
          for (int itk = 0; itk < 4; ++itk) { const int tk_ = itk * 32 + tr, pos = tok0 + tk_; const bf16_t* rp = P + (rowbase + tk_) * PP + cc;
              const u32x4 zero4 = (u32x4){0u, 0u, 0u, 0u};
              const u32x4 gb = *(const u32x4*)(rp + 2560), z1 = *(const u32x4*)(rp + 2048);
              const u32x4 z0 = pos > 0 ? *(const u32x4*)(rp - PP + 2048) : zero4, z2 = pos + 1 < T ? *(const u32x4*)(rp + PP + 2048) : zero4;
              float y[8];
#pragma unroll
              for (int e2 = 0; e2 < 4; ++e2) {
                  y[2 * e2] = bflo(gb[e2]) * (bflo(z0[e2]) * w0[2 * e2] + bflo(z1[e2]) * w1[2 * e2] + bflo(z2[e2]) * w2[2 * e2]);
                  y[2 * e2 + 1] = bfhi(gb[e2]) * (bfhi(z0[e2]) * w0[2 * e2 + 1] + bfhi(z1[e2]) * w1[2 * e2 + 1] + bfhi(z2[e2]) * w2[2 * e2 + 1]); }
              u32x4 w; w.x = cvtpk(y[0], y[1]); w.y = cvtpk(y[2], y[3]); w.z = cvtpk(y[4], y[5]); w.w = cvtpk(y[6], y[7]);
              *(u32x4*)(MIX + (rowbase + tk_) * 1024 + 512 + cc) = w; } }
    }
}

__device__ __forceinline__ void lat_phase(const Params& p, int G) {
    const int lane = threadIdx.x & 63, wave = threadIdx.x >> 6;
    const int gw = blockIdx.x * NWAVES + wave, NGW = G * NWAVES;
    const bf16_t* LAT = (const bf16_t*)(p.ws + WS_LAT16); bf16_t* QN = (bf16_t*)(p.ws + WS_QN); bf16_t* CKV = (bf16_t*)(p.ws + WS_CKV); bf16_t* KR = (bf16_t*)(p.ws + WS_KR);
    const f32x2* tab = (const f32x2*)(p.ws + WS_TAB);
    const float* qng = p.in[I_QNG]; const float* kvng = p.in[I_KVNG];
    for (int m = gw; m < KVROWS; m += NGW) {
        if (m < MROWS) {
            const bf16_t* lat = LAT + (size_t)m * 768;
            unsigned qw[3];
#pragma unroll
            for (int j = 0; j < 3; ++j) qw[j] = *(const unsigned*)(lat + 2 * lane + 128 * j);
            const u32x2 kw = *(const u32x2*)(lat + 384 + 4 * lane);
            const float kr = __uint_as_float((unsigned)lat[640 + lane] << 16);
            f32x2 qv[3]; float ssq = 0.f;
#pragma unroll
            for (int j = 0; j < 3; ++j) { qv[j] = (f32x2){bflo(qw[j]), bfhi(qw[j])}; ssq += qv[j].x * qv[j].x + qv[j].y * qv[j].y; }
            const f32x4 kv = (f32x4){bflo(kw.x), bfhi(kw.x), bflo(kw.y), bfhi(kw.y)};
            float ssk = (kv.x * kv.x + kv.y * kv.y) + (kv.z * kv.z + kv.w * kv.w);
#pragma unroll
            for (int o = 1; o < 64; o <<= 1) { ssq += __shfl_xor(ssq, o); ssk += __shfl_xor(ssk, o); }
            { const float rstd = rsqrtf(ssq * (1.f / 384.f) + EPS);
#pragma unroll
              for (int j = 0; j < 3; ++j) { const f32x2 gv = *(const f32x2*)(qng + 2 * lane + 128 * j); *(unsigned*)(QN + (size_t)m * 384 + 2 * lane + 128 * j) = cvtpk(qv[j].x * rstd * gv.x, qv[j].y * rstd * gv.y); } }
            const bool prompt = m < NPR; const int ms = m - NPR;
            const size_t kvrow = prompt ? (size_t)m : (size_t)NPR + (size_t)(ms >> 12) * 4608 + 512 + (ms & 4095);
            { const float rstd = rsqrtf(ssk * (1.f / 256.f) + EPS); const f32x4 gv = *(const f32x4*)(kvng + 4 * lane); const f32x4 ck = kv * rstd * gv;
              if (prompt) *(f32x4*)(p.out + OFF_CKV + (size_t)m * 256 + 4 * lane) = ck;
              u32x2 w; w.x = cvtpk(ck.x, ck.y); w.y = cvtpk(ck.z, ck.w); *(u32x2*)(CKV + kvrow * 256 + 4 * lane) = w; }
            { float outv = kr;
              if (prompt) p.out[OFF_KR + (size_t)m * 64 + lane] = kr;
              const float other = __shfl_xor(kr, 16);
              if (!prompt) { const int t = ms & 4095, half = lane >> 5, idx = lane & 31, fi = idx & 15, hi2 = idx >> 4; const int pos = half ? (t & 63) : (t >> 6);
                  const f32x2 cs = tab[pos * 16 + fi]; const float x1 = hi2 ? other : kr, x2 = hi2 ? kr : other; outv = hi2 ? (x1 * cs.y + x2 * cs.x) : (x1 * cs.x - x2 * cs.y); }
              KR[kvrow * 64 + lane] = f2bf(outv); }
        } else {
            const int cm = m - MROWS, b = cm >> 9, l = cm & 511; const size_t kvrow = (size_t)NPR + (size_t)b * 4608 + l;
            const f32x4 ck = __builtin_nontemporal_load((const f32x4*)(p.in[I_CCKV] + ((size_t)b * 512 + l) * 256 + 4 * lane));
            u32x2 w; w.x = cvtpk(ck.x, ck.y); w.y = cvtpk(ck.z, ck.w); *(u32x2*)(CKV + kvrow * 256 + 4 * lane) = w;
            KR[kvrow * 64 + lane] = f2bf(p.in[I_CKR][((size_t)b * 512 + l) * 64 + lane]);
        }
    }
}

__device__ __forceinline__ void final_norm_phase(const Params& p, int gwb, int nwb, int lo0, int hi0, int lo1, int hi1) {
    const int lane = threadIdx.x & 63, wave = threadIdx.x >> 6;
    const int gw = gwb * NWAVES + wave, NGW = nwb * NWAVES, n0_ = hi0 - lo0, total = n0_ + (hi1 - lo1);
    const float* g = p.in[I_FING]; const bf16_t* X2 = (const bf16_t*)(p.ws + WS_X2B);
    f32x4 gv[4];
#pragma unroll
    for (int j = 0; j < 4; ++j) gv[j] = *(const f32x4*)(g + 4 * lane + 256 * j);
    for (int i0 = gw; i0 < total; i0 += 2 * NGW) {
        const bool has1 = i0 + NGW < total; const int i1 = has1 ? i0 + NGW : i0;
        const int m0 = i0 < n0_ ? lo0 + i0 : lo1 + (i0 - n0_), m1 = i1 < n0_ ? lo0 + i1 : lo1 + (i1 - n0_);
        f32x4 v0[4], v1[4];
#pragma unroll
        for (int j = 0; j < 4; ++j) { const int c = 4 * lane + 256 * j; v0[j] = ld_row4(nullptr, X2 + (size_t)m0 * DM, c); v1[j] = ld_row4(nullptr, X2 + (size_t)m1 * DM, c); }
        float s0 = 0.f, s1 = 0.f;
#pragma unroll
        for (int j = 0; j < 4; ++j) { s0 += (v0[j].x * v0[j].x + v0[j].y * v0[j].y) + (v0[j].z * v0[j].z + v0[j].w * v0[j].w); s1 += (v1[j].x * v1[j].x + v1[j].y * v1[j].y) + (v1[j].z * v1[j].z + v1[j].w * v1[j].w); }
#pragma unroll
        for (int o = 1; o < 64; o <<= 1) { s0 += __shfl_xor(s0, o); s1 += __shfl_xor(s1, o); }
        const float r0 = rsqrtf(s0 * (1.f / DM) + EPS), r1 = rsqrtf(s1 * (1.f / DM) + EPS);
#pragma unroll
        for (int j = 0; j < 4; ++j) { const int c = 4 * lane + 256 * j;
            __builtin_nontemporal_store((v0[j] * r0) * gv[j], (f32x4*)(p.out + (size_t)m0 * DM + c)); if (has1) __builtin_nontemporal_store((v1[j] * r1) * gv[j], (f32x4*)(p.out + (size_t)m1 * DM + c)); }
    }
}

#define XB_TMO      128
#define XB_XCNT(j)  (256  + 64 * (j))
#define XB_XSUB(j)  (1280 + 64 * (j))
#define XB_XGEN(j)  (2304 + 64 * (j))
#define XB_TOP      3328
#define XB_TOPGEN   3392
#define XCD_BAR_WORDS 3456
#define XB_SPIN_CAP (1u << 18)

__device__ __forceinline__ unsigned xb_ld(unsigned* p)              { return __hip_atomic_load(p, __ATOMIC_RELAXED, __HIP_MEMORY_SCOPE_AGENT); }
__device__ __forceinline__ unsigned xb_add(unsigned* p, unsigned v) { return __hip_atomic_fetch_add(p, v, __ATOMIC_RELAXED, __HIP_MEMORY_SCOPE_AGENT); }
__device__ __forceinline__ unsigned xb_xcc_id() { return (unsigned)__builtin_amdgcn_s_getreg((3 << 11) | 20) & 0xFu; }
#define XB_SPIN(cond, bar) do { unsigned _sp = 0; while (cond) { __builtin_amdgcn_s_sleep(1); \
    if ((++_sp & 255u) == 0u) { if (xb_ld(&(bar)[XB_TMO])) break; if (_sp > XB_SPIN_CAP) { atomicAdd(&(bar)[XB_TMO], 1u); break; } } } } while (0)

struct XcdBarrier {
    unsigned* bar; unsigned x;
    volatile LAS unsigned* st;
};

__device__ __forceinline__ XcdBarrier xcd_barrier_post(unsigned* bar, volatile LAS unsigned* st) {
    XcdBarrier b; b.bar = bar; b.x = xb_xcc_id(); b.st = st;
    if (threadIdx.x == 0) (void)xb_add(&bar[XB_XCNT(b.x)], 1u);
    return b;
}
__device__ __forceinline__ void xcd_barrier_complete(unsigned* bar, unsigned x, unsigned& nloc, unsigned& nx) {
    const unsigned G = gridDim.x * gridDim.y * gridDim.z;
    unsigned sum, cnt, mine, sp = 0u;
    for (;;) {
        sum = 0u; cnt = 0u; mine = 0u;
#pragma unroll
        for (unsigned j = 0; j < 16; ++j) { const unsigned c = xb_ld(&bar[XB_XCNT(j)]); sum += c; cnt += (c > 0u) ? 1u : 0u; mine = (j == x) ? c : mine; }
        if (sum == G) break;
        __builtin_amdgcn_s_sleep(1);
        if ((++sp & 255u) == 0u) { if (xb_ld(&bar[XB_TMO])) break; if (sp > XB_SPIN_CAP) { atomicAdd(&bar[XB_TMO], 1u); break; } }
    }
    nloc = mine > 0u ? mine : 1u; nx = cnt > 0u ? cnt : 1u;
}

__device__ __forceinline__ void xcd_barrier(const XcdBarrier& b) {
    asm volatile("s_waitcnt vmcnt(0)" ::: "memory");
    __syncthreads();
    if (threadIdx.x == 0) {
        unsigned* bar = b.bar;
        __builtin_amdgcn_s_waitcnt(0);
        unsigned nloc = b.st[0], nx = b.st[1];
        if (nloc == 0u) { xcd_barrier_complete(bar, b.x, nloc, nx); b.st[0] = nloc; b.st[1] = nx; }
        const unsigned old = xb_add(&bar[XB_XSUB(b.x)], 1u);
        const unsigned gen = old / nloc;
        if (old + 1u == (gen + 1u) * nloc) {
            __builtin_amdgcn_fence(__ATOMIC_RELEASE, "agent");
            asm volatile("s_waitcnt vmcnt(0)" ::: "memory");
            const unsigned og = xb_add(&bar[XB_TOP], 1u);
            const unsigned tg = og / nx;
            if (og + 1u == (tg + 1u) * nx) xb_add(&bar[XB_TOPGEN], 1u);
            else XB_SPIN(xb_ld(&bar[XB_TOPGEN]) == tg, bar);
            __builtin_amdgcn_fence(__ATOMIC_ACQUIRE, "agent");
            xb_add(&bar[XB_XGEN(b.x)], 1u);
            asm volatile("s_waitcnt vmcnt(0)" ::: "memory");
        } else {
            XB_SPIN(xb_ld(&bar[XB_XGEN(b.x)]) == gen, bar);
            __builtin_amdgcn_fence(__ATOMIC_ACQUIRE, "agent");
            asm volatile("s_waitcnt vmcnt(0)" ::: "memory");
        }
    }
    __syncthreads();
}

namespace att {
constexpr int NW = 8, QBLK = 32, KVBLK = 64;
constexpr float SCALE = 0.07216878364870322f;
constexpr float THR = 8.f;
constexpr int SDEPTH = 1;
constexpr int LDQ = 1536, LDK = 2048, LDR = 64, LDO = 1024;
constexpr int SHM_V = KVBLK * 128 * 2, SHM_K = KVBLK * 192 * 2;
constexpr int NQR = 6;
constexpr int SHM_ATTN = 2 * SHM_V + 2 * SHM_K + NW * 64 * 4 + NW * (12 - NQR) * 1024;
#define KSWZ(row, colB) ((row) * 384 + ((colB) ^ (((row) & 7) << 4)))
#define SBAR() __builtin_amdgcn_sched_barrier(0)
__device__ __forceinline__ unsigned cvtpk_a(float lo, float hi) { unsigned r; asm volatile("v_cvt_pk_bf16_f32 %0, %1, %2" : "=v"(r) : "v"(lo), "v"(hi)); return r; }

__device__ __forceinline__ void partialSM(f32x16& p0, f32x16& p1, float& m_reg, float& mn, float& alpha) {
  constexpr float C = SCALE * 1.4426950408889634f;
  float pmax = p0[0];
#pragma unroll
  for (int r = 1; r < 16; ++r) pmax = fmaxf(pmax, p0[r]);
#pragma unroll
  for (int r = 0; r < 16; ++r) pmax = fmaxf(pmax, p1[r]);
  { auto rr = __builtin_amdgcn_permlane32_swap(__float_as_uint(pmax), __float_as_uint(pmax), false, false);
    pmax = fmaxf(__uint_as_float(rr[0]), __uint_as_float(rr[1])); }
  if (__builtin_expect(__all(pmax - m_reg <= THR / SCALE), 1)) { mn = m_reg; alpha = 1.f; }
  else { mn = fmaxf(m_reg, pmax); alpha = __builtin_amdgcn_exp2f((m_reg - mn) * C); m_reg = mn; }
  float mnC = -mn * C;
#pragma unroll
  for (int r = 0; r < 16; ++r) p0[r] = fmaf(p0[r], C, mnC);
#pragma unroll
  for (int r = 0; r < 16; ++r) p1[r] = fmaf(p1[r], C, mnC);
#pragma unroll
  for (int r = 0; r < 16; ++r) p0[r] = __builtin_amdgcn_exp2f(p0[r]);
}
__device__ __forceinline__ void finishSM(f32x16& p0, f32x16& p1, float alpha, float& l_reg, bf16x8& pa0, bf16x8& pa1, bf16x8& pa2, bf16x8& pa3) {
#pragma unroll
  for (int r = 0; r < 16; ++r) p1[r] = __builtin_amdgcn_exp2f(p1[r]);
  float ps = 0;
#pragma unroll
  for (int r = 0; r < 16; ++r) ps += p0[r];
#pragma unroll
  for (int r = 0; r < 16; ++r) ps += p1[r];
  { auto rr = __builtin_amdgcn_permlane32_swap(__float_as_uint(ps), __float_as_uint(ps), false, false);
    ps = __uint_as_float(rr[0]) + __uint_as_float(rr[1]); }
  l_reg = l_reg * alpha + ps;
#define PK4(P, BASE, OUT) do { unsigned a0 = cvtpk_a(P[BASE + 0], P[BASE + 1]), a1 = cvtpk_a(P[BASE + 2], P[BASE + 3]);   \
    unsigned b0 = cvtpk_a(P[BASE + 4], P[BASE + 5]), b1 = cvtpk_a(P[BASE + 6], P[BASE + 7]);                              \
    auto r0 = __builtin_amdgcn_permlane32_swap(a0, b0, false, false); auto r1 = __builtin_amdgcn_permlane32_swap(a1, b1, false, false); \
    u32x4 w = {r0[0], r1[0], r0[1], r1[1]}; OUT = *reinterpret_cast<bf16x8*>(&w); } while (0)
  PK4(p0, 0, pa0); PK4(p0, 8, pa1); PK4(p1, 0, pa2); PK4(p1, 8, pa3);
#undef PK4
}
__device__ __forceinline__ void qkt(f32x16& p0, f32x16& p1, const char* Ks, const bf16x8* qr, const char* qlds, int r32, int hi) {
  p0 = f32x16{}; p1 = f32x16{};
#pragma unroll
  for (int d0 = 0; d0 < 12; ++d0) { int cb = (d0 * 16 + hi * 8) * 2;
    bf16x8 b0 = *reinterpret_cast<const bf16x8*>(Ks + KSWZ(r32, cb));
    bf16x8 b1 = *reinterpret_cast<const bf16x8*>(Ks + KSWZ(32 + r32, cb));
    const bf16x8 qf = d0 < NQR ? qr[d0 < NQR ? d0 : 0] : *reinterpret_cast<const bf16x8*>(qlds + (d0 - NQR) * 1024);
    p0 = __builtin_amdgcn_mfma_f32_32x32x16_bf16(b0, qf, p0, 0, 0, 0);
    p1 = __builtin_amdgcn_mfma_f32_32x32x16_bf16(b1, qf, p1, 0, 0, 0); }
}
__device__ __forceinline__ int v_st(int k, int c) { const int kk = (k & ~0xC) | ((k & 4) << 1) | ((k & 8) >> 1); return ((kk >> 3) * 4 + (c >> 5)) * 512 + ((kk & 7) * 32 + (c & 31)) * 2; }
__device__ __forceinline__ int v_rd_base(int lane) { return ((lane & 3) << 3) | (((lane >> 2) & 3) << 6) | (((lane >> 4) & 1) << 5) | (((lane >> 5) & 1) << 8); }
constexpr int v_rd_off(int d0, int ks, int half) { return d0 * 512 + ks * 4096 + half * 2048; }
template <int OFF> __device__ __forceinline__ s16x4 tr_read(int vb) {
  s16x4 r; asm volatile("ds_read_b64_tr_b16 %0, %1 offset:%2" : "=&v"(r) : "v"(vb), "i"(OFF) : "memory"); return r;
}
template <int D0> __device__ __forceinline__ void pv_one(f32x16& od, int vb, bf16x8 pa0, bf16x8 pa1, bf16x8 pa2, bf16x8 pa3) {
  const s16x4 l0 = tr_read<v_rd_off(D0, 0, 0)>(vb), h0 = tr_read<v_rd_off(D0, 0, 1)>(vb), l1 = tr_read<v_rd_off(D0, 1, 0)>(vb), h1 = tr_read<v_rd_off(D0, 1, 1)>(vb);
  const s16x4 l2 = tr_read<v_rd_off(D0, 2, 0)>(vb), h2 = tr_read<v_rd_off(D0, 2, 1)>(vb), l3 = tr_read<v_rd_off(D0, 3, 0)>(vb), h3 = tr_read<v_rd_off(D0, 3, 1)>(vb);
  asm volatile("s_waitcnt lgkmcnt(0)" ::: "memory"); SBAR();
#define PK(Lx, Hx) (bf16x8){Lx[0], Lx[1], Lx[2], Lx[3], Hx[0], Hx[1], Hx[2], Hx[3]}
  od = __builtin_amdgcn_mfma_f32_32x32x16_bf16(pa0, PK(l0, h0), od, 0, 0, 0);
  od = __builtin_amdgcn_mfma_f32_32x32x16_bf16(pa1, PK(l1, h1), od, 0, 0, 0);
  od = __builtin_amdgcn_mfma_f32_32x32x16_bf16(pa2, PK(l2, h2), od, 0, 0, 0);
  od = __builtin_amdgcn_mfma_f32_32x32x16_bf16(pa3, PK(l3, h3), od, 0, 0, 0);
#undef PK
}
__device__ __forceinline__ void pv_d0(f32x16* o, int vb, bf16x8 pa0, bf16x8 pa1, bf16x8 pa2, bf16x8 pa3) {
  pv_one<0>(o[0], vb, pa0, pa1, pa2, pa3); pv_one<1>(o[1], vb, pa0, pa1, pa2, pa3); pv_one<2>(o[2], vb, pa0, pa1, pa2, pa3); pv_one<3>(o[3], vb, pa0, pa1, pa2, pa3);
}

constexpr int NSLOT = 3, LDS_KR = 0, LDS_VR = NSLOT * SHM_K, LDS_SC = LDS_VR + NSLOT * SHM_V, LDS_Q11 = LDS_SC + NW * 64 * 4, ATT_LDS = LDS_Q11 + NW * 1024;
#define ATT_WAITBAR(N) asm volatile("s_waitcnt vmcnt(" #N ") lgkmcnt(0)\n\ts_barrier" ::: "memory")
__device__ __forceinline__ void qkt3(f32x16& p0, f32x16& p1, const LAS char* Ks, const bf16x8* qr, int baseN, int XN, int baseR, int XR) {
  p0 = f32x16{}; p1 = f32x16{};
#pragma unroll
  for (int d0 = 0; d0 < 8; ++d0) { const int ad = baseN + ((32 * d0) ^ XN);
    bf16x8 b0 = *reinterpret_cast<const LAS bf16x8*>(Ks + ad);
    bf16x8 b1 = *reinterpret_cast<const LAS bf16x8*>(Ks + ad + 8192);
    p0 = __builtin_amdgcn_mfma_f32_32x32x16_bf16(b0, qr[d0], p0, 0, 0, 0);
    p1 = __builtin_amdgcn_mfma_f32_32x32x16_bf16(b1, qr[d0], p1, 0, 0, 0); }
#pragma unroll
  for (int d0 = 8; d0 < 12; ++d0) { const int ad = baseR + ((32 * (d0 - 8)) ^ XR);
    bf16x8 b0 = *reinterpret_cast<const LAS bf16x8*>(Ks + ad);
    bf16x8 b1 = *reinterpret_cast<const LAS bf16x8*>(Ks + ad + 4096);
    p0 = __builtin_amdgcn_mfma_f32_32x32x16_bf16(b0, qr[d0], p0, 0, 0, 0);
    p1 = __builtin_amdgcn_mfma_f32_32x32x16_bf16(b1, qr[d0], p1, 0, 0, 0); }
}
#define LDK128(dst, addr, OFFS) asm volatile("ds_read_b128 %0, %1 offset:%2" : "=&v"(dst) : "v"(addr), "n"(OFFS) : "memory")
#define LWAIT0() asm volatile("s_waitcnt lgkmcnt(0)" ::: "memory")
#define KAD(d0) ((d0) < 8 ? (unsigned)(ksl + baseN + ((32 * (d0)) ^ XN)) : (unsigned)(ksl + baseR + ((32 * ((d0) - 8)) ^ XR)))
#define KISSUE(F, j0) do { _Pragma("unroll") for (int t_ = 0; t_ < 3; ++t_) { const unsigned ad_ = KAD((j0) + t_); \
    if ((j0) + t_ < 8) { LDK128(F[2 * t_], ad_, 0); LDK128(F[2 * t_ + 1], ad_, 8192); } else { LDK128(F[2 * t_], ad_, 0); LDK128(F[2 * t_ + 1], ad_, 4096); } } } while (0)
#define KMFMA(F, j0) do { _Pragma("unroll") for (int t_ = 0; t_ < 3; ++t_) { \
    p0 = __builtin_amdgcn_mfma_f32_32x32x16_bf16(F[2 * t_], qr[(j0) + t_], p0, 0, 0, 0); p1 = __builtin_amdgcn_mfma_f32_32x32x16_bf16(F[2 * t_ + 1], qr[(j0) + t_], p1, 0, 0, 0); } } while (0)
#define QK_HEAD(FA) KISSUE(FA, 0)
#define QK_BODY(FA, FB) do { p0 = f32x16{}; p1 = f32x16{}; \
    SBAR(); LWAIT0(); KISSUE(FB, 3); SBAR(); KMFMA(FA, 0); \
    SBAR(); LWAIT0(); KISSUE(FA, 6); SBAR(); KMFMA(FB, 3); \
    SBAR(); LWAIT0(); KISSUE(FB, 9); SBAR(); KMFMA(FA, 6); \
    SBAR(); LWAIT0(); SBAR(); KMFMA(FB, 9); SBAR(); } while (0)
#define VISSUE(Lx, Hx, D0) do { Lx[0] = tr_read<v_rd_off(D0, 0, 0)>(vb); Hx[0] = tr_read<v_rd_off(D0, 0, 1)>(vb); Lx[1] = tr_read<v_rd_off(D0, 1, 0)>(vb); Hx[1] = tr_read<v_rd_off(D0, 1, 1)>(vb); \
    Lx[2] = tr_read<v_rd_off(D0, 2, 0)>(vb); Hx[2] = tr_read<v_rd_off(D0, 2, 1)>(vb); Lx[3] = tr_read<v_rd_off(D0, 3, 0)>(vb); Hx[3] = tr_read<v_rd_off(D0, 3, 1)>(vb); } while (0)
#define VPK(Lx, Hx, i) (bf16x8){Lx[i][0], Lx[i][1], Lx[i][2], Lx[i][3], Hx[i][0], Hx[i][1], Hx[i][2], Hx[i][3]}
#define VMFMA(od, Lx, Hx) do { od = __builtin_amdgcn_mfma_f32_32x32x16_bf16(pa0, VPK(Lx, Hx, 0), od, 0, 0, 0); od = __builtin_amdgcn_mfma_f32_32x32x16_bf16(pa1, VPK(Lx, Hx, 1), od, 0, 0, 0); \
    od = __builtin_amdgcn_mfma_f32_32x32x16_bf16(pa2, VPK(Lx, Hx, 2), od, 0, 0, 0); od = __builtin_amdgcn_mfma_f32_32x32x16_bf16(pa3, VPK(Lx, Hx, 3), od, 0, 0, 0); } while (0)
__device__ __forceinline__ void attn_unit(const bf16_t* __restrict__ Qb, const bf16_t* __restrict__ Kn, const bf16_t* __restrict__ Vh, const bf16_t* __restrict__ Kr,
                                          const bf16_t* Gi, bf16_t* Go, int seq, LAS unsigned char* L, const f32x2* __restrict__ tab, int t0) {
  const int tid = threadIdx.x, wid = __builtin_amdgcn_readfirstlane(tid >> 6), lane = tid & 63, r32 = lane & 31, hi = lane >> 5;
  const LAS char* K_lds = (const LAS char*)L + LDS_KR;
  LAS float* ws = (LAS float*)(L + LDS_SC) + wid * 64; LAS float* li_l = ws; LAS float* al_l = ws + 32;
  const char* kp[3]; int kst[3]; const char* vp[2];
#pragma unroll
  for (int i = 0; i < 2; ++i) { const int o = (wid + 8 * i) * 1024 + lane * 16, row = o >> 8, s = (o >> 4) & 15, c4 = s ^ ((row & 7) | (((row >> 4) & 1) << 3));
    kp[i] = (const char*)(Kn + (long)row * LDK + c4 * 8); kst[i] = KVBLK * LDK * 2; }
  { const int o = wid * 1024 + lane * 16, line = o >> 8, s = (o >> 4) & 15, row = 32 * (line >> 4) + 16 * (s >> 3) + (line & 15), c4 = (s & 7) ^ (row & 7);
    kp[2] = (const char*)(Kr + (long)row * LDR + c4 * 8); kst[2] = KVBLK * LDR * 2; }
  const int gq = (r32 & 7) | (((r32 >> 4) & 1) << 3);
  const int baseN = r32 * 256, XN = 16 * (hi ^ gq), baseR = 16384 + (r32 & 15) * 256 + 128 * ((r32 >> 4) & 1), XR = 16 * (hi ^ (r32 & 7));
#pragma unroll
  for (int i = 0; i < 2; ++i) { const int o = (wid + 8 * i) * 1024 + lane * 16, sub = o >> 9, kk = (sub >> 2) * 8 + ((o & 511) >> 6), c = (sub & 3) * 32 + ((o & 63) >> 1);
    const int k = (kk & ~0xC) | ((kk & 4) << 1) | ((kk & 8) >> 1); vp[i] = (const char*)(Vh + (long)k * LDK + c); }
#define DMA_K(slot) do { _Pragma("unroll") for (int i_ = 0; i_ < 3; ++i_) { __builtin_amdgcn_global_load_lds((const unsigned*)kp[i_], (LAS unsigned*)(L + LDS_KR + (slot) * SHM_K + (wid + 8 * i_) * 1024), 16, 0, 0); kp[i_] += kst[i_]; } } while (0)
#define DMA_V(slot) do { _Pragma("unroll") for (int i_ = 0; i_ < 2; ++i_) { __builtin_amdgcn_global_load_lds((const unsigned*)vp[i_], (LAS unsigned*)(L + LDS_VR + (slot) * SHM_V + (wid + 8 * i_) * 1024), 16, 0, 0); vp[i_] += KVBLK * LDK * 2; } } while (0)
  const int NT = seq / KVBLK;
  DMA_K(0); DMA_V(0); DMA_K(1); DMA_V(1);
  float m_reg = -1e30f, l_reg = 0; f32x16 o[4] = {}; bf16x8 qr[12];
  const bf16_t* Qw = Qb + (long)(wid * QBLK + r32) * LDQ + hi * 8;
#pragma unroll
  for (int d0 = 0; d0 < 8; ++d0) qr[d0] = *reinterpret_cast<const bf16x8*>(Qw + d0 * 16);
  {
    u32x4 qp[4];
#pragma unroll
    for (int d0 = 0; d0 < 4; ++d0) qp[d0] = *reinterpret_cast<const u32x4*>(Qw + 128 + d0 * 16);
    if (t0 >= 0) { const int t = t0 + wid * QBLK + r32;
#pragma unroll
      for (int pr = 0; pr < 2; ++pr) { const int pos = pr == 0 ? (t >> 6) : (t & 63); const f32x2* tp = tab + pos * 16 + hi * 8;
#pragma unroll
        for (int e2 = 0; e2 < 4; ++e2) { const f32x2 c0 = tp[2 * e2], c1 = tp[2 * e2 + 1];
          const float a0 = bflo(qp[2 * pr][e2]), a1 = bfhi(qp[2 * pr][e2]), b0 = bflo(qp[2 * pr + 1][e2]), b1 = bfhi(qp[2 * pr + 1][e2]);
          qp[2 * pr][e2] = cvtpk(a0 * c0.x - b0 * c0.y, a1 * c1.x - b1 * c1.y); qp[2 * pr + 1][e2] = cvtpk(a0 * c0.y + b0 * c0.x, a1 * c1.y + b1 * c1.x); } } }
#pragma unroll
    for (int d0 = 0; d0 < 3; ++d0) qr[8 + d0] = __builtin_bit_cast(bf16x8, qp[d0]);
    *(LAS u32x4*)(L + LDS_Q11 + wid * 1024 + lane * 16) = qp[3]; }
  const int vb0 = (int)(unsigned)(uintptr_t)(L + LDS_VR) + v_rd_base(lane);
#define RESC(a) do { if (__any((a) < 1.f)) { if (hi == 0) al_l[r32] = (a); asm volatile("s_waitcnt lgkmcnt(0)" ::: "memory"); \
    _Pragma("unroll") for (int d = 0; d < 4; ++d) _Pragma("unroll") for (int r = 0; r < 16; ++r) o[d][r] *= al_l[crow(r, hi)]; } } while (0)
  ATT_WAITBAR(0);
  if (wid >= 4) ATT_WAITBAR(0);
  int sj = 0;
#pragma unroll 1
  for (int j = 0; j < NT; ++j) {
    f32x16 p0, p1; float mnC, alC;
    {
      const unsigned ksl = (unsigned)(uintptr_t)(K_lds + sj * SHM_K);
      bf16x8 FA[6], FB[6];
      qr[11] = *(const LAS bf16x8*)(L + LDS_Q11 + wid * 1024 + lane * 16);
      QK_HEAD(FA);
      QK_BODY(FA, FB);
      partialSM(p0, p1, m_reg, mnC, alC);
      RESC(alC); }
    ATT_WAITBAR(0);
    {
      const int vb = vb0 + sj * SHM_V;
      s16x4 LA[4], HA[4], LB[4], HB[4]; bf16x8 pa0, pa1, pa2, pa3;
      VISSUE(LA, HA, 0);
      if (j + 2 < NT) { const int s2 = sj == 0 ? 2 : sj - 1; DMA_V(s2); DMA_K(s2); }
      SBAR(); finishSM(p0, p1, alC, l_reg, pa0, pa1, pa2, pa3); SBAR();
      LWAIT0(); VISSUE(LB, HB, 1); SBAR(); VMFMA(o[0], LA, HA);
      SBAR(); LWAIT0(); VISSUE(LA, HA, 2); SBAR(); VMFMA(o[1], LB, HB);
      SBAR(); LWAIT0(); VISSUE(LB, HB, 3); SBAR(); VMFMA(o[2], LA, HA);
      SBAR(); LWAIT0(); SBAR(); VMFMA(o[3], LB, HB); }
    if (j + 2 < NT) ATT_WAITBAR(5); else ATT_WAITBAR(0);
    sj = sj == 2 ? 0 : sj + 1;
  }
  if (wid < 4) ATT_WAITBAR(0);
  if (hi == 0) li_l[r32] = l_reg; asm volatile("s_waitcnt lgkmcnt(0)" ::: "memory");
  unsigned stg_a = (unsigned)(uintptr_t)(L + wid * 8192); asm volatile("" : "+v"(stg_a));
  int lane_e = lane; asm volatile("" : "+v"(lane_e));
  LAS char* stg = (LAS char*)(uintptr_t)(stg_a + (unsigned)(((lane_e >> 5) * 4 * 128 + (lane_e & 31)) * 2));
#pragma unroll
  for (int r = 0; r < 16; ++r) { const float rl = __builtin_amdgcn_rcpf(li_l[crow(r, hi)]);
#pragma unroll
    for (int d0 = 0; d0 < 4; ++d0) *(LAS bf16_t*)(stg + ((r & 3) + 8 * (r >> 2)) * 256 + d0 * 64) = f2bf(o[d0][r] * rl); }
  stg = (LAS char*)(uintptr_t)stg_a;
  asm volatile("s_waitcnt lgkmcnt(0)" ::: "memory");
  { const bf16_t* Gw = Gi + (long)(wid * QBLK) * LDO; bf16_t* Ow = Go + (long)(wid * QBLK) * LDO;
#pragma unroll 1
    for (int ib_ = 0; ib_ < 2; ++ib_) {
      u32x4 gt[4];
#pragma unroll
      for (int i = 0; i < 4; ++i) { const int n = lane + 64 * (4 * ib_ + i); gt[i] = *(const u32x4*)(Gw + (long)(n >> 4) * LDO + (n & 15) * 8); }
#pragma unroll
      for (int i = 0; i < 4; ++i) { const int n = lane + 64 * (4 * ib_ + i); const u32x4 ov = *(const LAS u32x4*)(stg + n * 16); const u32x4 g = gt[i]; u32x4 w;
        w.x = cvtpk(bflo(ov.x) * silu_f(bflo(g.x)), bfhi(ov.x) * silu_f(bfhi(g.x))); w.y = cvtpk(bflo(ov.y) * silu_f(bflo(g.y)), bfhi(ov.y) * silu_f(bfhi(g.y)));
        w.z = cvtpk(bflo(ov.z) * silu_f(bflo(g.z)), bfhi(ov.z) * silu_f(bfhi(g.z))); w.w = cvtpk(bflo(ov.w) * silu_f(bflo(g.w)), bfhi(ov.w) * silu_f(bfhi(g.w)));
        *(u32x4*)(Ow + (long)(n >> 4) * LDO + (n & 15) * 8) = w; } } }
  asm volatile("s_waitcnt vmcnt(0) lgkmcnt(0)\n\ts_barrier" ::: "memory");
#undef DMA_K
#undef DMA_V
#undef RESC
#undef ROT
#undef STEP
}
#undef SBAR
}

__device__ __forceinline__ void attn_phase(const Params& p, LAS unsigned char* lds, int G, bool dummy) {
    const bf16_t* Q = (const bf16_t*)(p.ws + WS_LATQ); const bf16_t* KV = (const bf16_t*)(p.ws + WS_KV); const bf16_t* KR = (const bf16_t*)(p.ws + WS_KR); bf16_t* GT = (bf16_t*)(p.ws + WS_GATE);
    for (int u = blockIdx.x; u < 1280; u += G) {
        size_t qrow, krow; int hh, seq, t0;
        if (u < 1024) { const int v = u & 255, k = u >> 8, xcd = v & 7, idx = v >> 3; const int bh = k * 16 + xcd * 2 + (idx >> 4), qb = idx & 15; const int b = bh >> 3; hh = bh & 7;
            qrow = (size_t)NPR + (size_t)b * 4096 + (size_t)qb * 256; krow = (size_t)NPR + (size_t)b * 4608; seq = 4608; t0 = qb * 256; }
        else { const int pu = u - 1024; const int b = pu >> 3; hh = pu & 7; qrow = (size_t)b * 256; krow = qrow; seq = 256; t0 = -1; }
        att::attn_unit(Q + qrow * 1536 + hh * 192, KV + krow * 2048 + hh * 256, KV + krow * 2048 + hh * 256 + 128, KR + krow * 64, GT + qrow * 1024 + hh * 128, dummy ? (bf16_t*)(p.ws + WS_ACT + 64 * MiB) : GT + qrow * 1024 + hh * 128, seq, lds, (const f32x2*)(p.ws + WS_TAB), t0);
    }
}

#ifndef MK_SINGLE
#define MK_SINGLE 1
#endif
constexpr int N_PHASES = 14;
struct KArgs { Params p; int ph_lo, ph_hi; };

__global__ void __launch_bounds__(NTHREADS, 2) mk_fwd(KArgs a) {
    extern __shared__ __attribute__((aligned(16))) unsigned char lds[];
    cg::grid_group grid = cg::this_grid();
    const Params& p = a.p; const int G = gridDim.x;
    LAS char* L = (LAS char*)lds;
    volatile LAS unsigned* MISC = (volatile LAS unsigned*)((LAS unsigned char*)lds + 147456 - 128);
    if (threadIdx.x < 16) MISC[threadIdx.x] = 0u;
    if (blockIdx.x == 0) { unsigned* bw = (unsigned*)(p.ws + WS_BAR);
        for (int i = threadIdx.x; i < XCD_BAR_WORDS; i += NTHREADS) __hip_atomic_store(bw + i, 0u, __ATOMIC_RELAXED, __HIP_MEMORY_SCOPE_AGENT);
        asm volatile("s_waitcnt vmcnt(0)" ::: "memory"); }
    __syncthreads();
    XcdBarrier bar; bar.bar = (unsigned*)(p.ws + WS_BAR); bar.x = 0; bar.st = MISC + 8;
    unsigned char* ws = p.ws;
    float* mod = (float*)(ws + WS_MOD);
    bf16_t* ACT = (bf16_t*)(ws + WS_ACT);
#ifndef PH
#define PH -1
#endif
#define IN(k) ((PH < 0 || PH == (k)) && a.ph_lo <= (k) && (k) < a.ph_hi)
#ifndef DUPMASK
#define DUPMASK 0
#endif
#define DUP(k) (((DUPMASK) >> (k)) & 1)
#define SEAM(k) do { if (a.ph_lo <= (k) && (k) + 1 < a.ph_hi) { if ((k) == 0) grid.sync(); else xcd_barrier(bar); } } while (0)
#define RUN_GEMM(EPI, Aptr, Bptr, M_, N_, K_, ...) do { pg8::Gemm g{(const bf16_t*)(Aptr), (const bf16_t*)(Bptr), (M_), (N_), (K_)}; pg8::StaticOrder S; S.init((M_), (N_), G, (int)blockIdx.x); \
        pg8::EPI E{__VA_ARGS__}; pg8::gemm_phase<pg8::EPI, pg8::StaticOrder, true, true>((PG8_LAS unsigned char*)lds, g, S, E); } while (0)

#ifdef NSYNC_EXTRA
    for (int i_ = 0; i_ < NSYNC_EXTRA; ++i_) grid.sync();
#endif
    if (IN(0)) { if (DUP(0)) { p0_phase(p, L, G); grid.sync(); } p0_phase(p, L, G); }
    SEAM(0);
    if (a.ph_lo <= 0 && 1 < a.ph_hi) bar = xcd_barrier_post((unsigned*)(p.ws + WS_BAR), MISC + 8);
    if (IN(1)) norm_mod_phase(p.in[I_XP], p.in[I_XS], nullptr, p.in[I_NORMG], mod, ACT, (int)blockIdx.x, G, 0, MROWS, 0, 0);
    SEAM(1);
    if (IN(2)) { if (DUP(2)) { RUN_GEMM(EpiBf16S, ACT, ws + WS_W_EIN, MROWS, 4096, 1024, (bf16_t*)(ws + WS_P), PP, 2, 4, 0.08838834764831845f, 1 << 30, nullptr, 0, 8, 2048); grid.sync(); } RUN_GEMM(EpiBf16S, ACT, ws + WS_W_EIN, MROWS, 4096, 1024, (bf16_t*)(ws + WS_P), PP, 2, 4, 0.08838834764831845f, 1 << 30, nullptr, 0, 8, 2048); }
    SEAM(2);
    if (IN(3)) ret_local_phase(p, L, G);
    SEAM(3);
    if (IN(4)) ret_scan2_phase(p, G);
    SEAM(4);
    if (IN(5)) { if (DUP(5)) { ret_out_phase(p, L, G); grid.sync(); } ret_out_phase(p, L, G); }
    SEAM(5);
#define RUN_PART(PM0, MSUB, GS, XP_, XS_, B16_, O16_, MODL_, Aptr, Bptr) do { pg8::Gemm g{(const bf16_t*)(Aptr) + (size_t)(PM0) * 256 * 1024, (const bf16_t*)(Bptr), (MSUB), 1024, 1024}; \
        pg8::StaticOrder S; S.init((MSUB), 1024, (GS), (int)blockIdx.x); pg8::EpiRes E{(XP_), (XS_), (B16_), (O16_), (MODL_), (PM0)}; \
        pg8::gemm_phase<pg8::EpiRes, pg8::StaticOrder, true, true>((PG8_LAS unsigned char*)lds, g, S, E); } while (0)
#define RUN_SPLIT(XP_, XS_, B16_, O16_, MODL_, Aptr, Bptr, OTHER) do { \
        RUN_PART(0, 32768, G, XP_, XS_, B16_, O16_, MODL_, Aptr, Bptr); \
        xcd_barrier(bar); \
        { const int Gs = G >> 1; if ((int)blockIdx.x < Gs) RUN_PART(128, MROWS - 32768, Gs, XP_, XS_, B16_, O16_, MODL_, Aptr, Bptr); else { OTHER; } } } while (0)
    if (IN(6)) RUN_SPLIT(p.in[I_XP], p.in[I_XS], nullptr, (bf16_t*)p.out, mod, ACT, ws + WS_W_EOUT,
                         norm_mod_phase(nullptr, nullptr, (const bf16_t*)p.out, p.in[I_NORMG] + DM, mod + 9 * 3072, ACT, (int)blockIdx.x - Gs, G - Gs, 0, 32768, 0, 0));
    SEAM(6);
    if (IN(7)) norm_mod_phase(nullptr, nullptr, (const bf16_t*)p.out, p.in[I_NORMG] + DM, mod + 9 * 3072, ACT, (int)blockIdx.x, G, 32768, MROWS, 0, 0);
    SEAM(7);
    if (IN(8)) { if (DUP(8)) { RUN_GEMM(EpiBf16S, ACT, ws + WS_W_OIN, MROWS, 1792, 1024, (bf16_t*)(ws + WS_GATE), 1024, 0, 0, 1.f, 4, (bf16_t*)(ws + WS_LAT16), 768, 1 << 30, 0); grid.sync(); } RUN_GEMM(EpiBf16S, ACT, ws + WS_W_OIN, MROWS, 1792, 1024, (bf16_t*)(ws + WS_GATE), 1024, 0, 0, 1.f, 4, (bf16_t*)(ws + WS_LAT16), 768, 1 << 30, 0); }
    SEAM(8);
    if (IN(9)) { if (DUP(9)) { lat_phase(p, G); grid.sync(); } lat_phase(p, G); }
    SEAM(9);
    if (IN(10)) {
#pragma unroll 1
      for (int rep9 = DUP(10) ? 0 : 1; rep9 < 2; ++rep9) {
        RUN_GEMM(EpiBf16S, ws + WS_QN, ws + WS_W_QUP, MROWS, 1536, 384, (bf16_t*)(ws + WS_LATQ), 1536, 0, 0, 1.f, 1 << 30, nullptr, 0, 1 << 30, 0);
        RUN_GEMM(EpiBf16S, ws + WS_CKV, ws + WS_W_KVUP, KVROWS, 2048, 256, (bf16_t*)(ws + WS_KV), 2048, 0, 0, 1.f, 1 << 30, nullptr, 0, 1 << 30, 0);
        if (rep9 == 0) grid.sync(); }
    }
    SEAM(10);
    if (IN(11)) {
#if DUPMASK & (1 << 11)
#pragma unroll 1
        for (int rep = 0; rep < 2; ++rep) { attn_phase(p, (LAS unsigned char*)lds, G, rep == 0); if (rep == 0) xcd_barrier(bar); }
#else
        attn_phase(p, (LAS unsigned char*)lds, G, false);
#endif
    }
    SEAM(11);
    if (IN(12)) RUN_SPLIT(nullptr, nullptr, (const bf16_t*)p.out, (bf16_t*)(ws + WS_X2B), mod + 9 * 3072, ws + WS_GATE, ws + WS_W_OOUT,
                          final_norm_phase(p, (int)blockIdx.x - Gs, G - Gs, 0, 16384, 20480, 32768));
    SEAM(12);
    if (IN(13)) final_norm_phase(p, (int)blockIdx.x, G, 16384, 20480, 32768, MROWS);
#undef IN
#undef SEAM
#undef RUN_GEMM
}

extern "C" void kernel_launch(void* const* d_in, const int* in_sizes, int n_in, void* d_out, int out_size, void* d_ws, size_t ws_size, hipStream_t stream) {
    static int grid = 0;
    if (grid == 0) {
        if (n_in != 21 || in_sizes[0] != NPR * DM || in_sizes[1] != 32768 * DM || (size_t)out_size != OUT_TOTAL || ws_size < WS_END) {
            fprintf(stderr, "kernel_launch: unexpected shapes: n_in %d in0 %d in1 %d out %d ws %zu (need >= %zu)\n", n_in, n_in > 0 ? in_sizes[0] : -1, n_in > 1 ? in_sizes[1] : -1, out_size, ws_size, (size_t)WS_END);
            grid = -1; return; }
        int dev = 0, cus = 0, per_cu = 0;
        if (hipGetDevice(&dev) != hipSuccess || hipDeviceGetAttribute(&cus, hipDeviceAttributeMultiprocessorCount, dev) != hipSuccess) { fprintf(stderr, "kernel_launch: device query failed\n"); grid = -1; return; }
        if (hipFuncSetAttribute((const void*)mk_fwd, hipFuncAttributeMaxDynamicSharedMemorySize, LDS_BYTES) != hipSuccess) { fprintf(stderr, "kernel_launch: hipFuncSetAttribute failed\n"); grid = -1; return; }
        if (hipOccupancyMaxActiveBlocksPerMultiprocessor(&per_cu, (const void*)mk_fwd, NTHREADS, LDS_BYTES) != hipSuccess || per_cu < 1) { fprintf(stderr, "kernel_launch: occupancy query says %d blocks per CU\n", per_cu); (void)hipGetLastError(); grid = -1; return; }
        grid = cus * per_cu;
    }
    if (grid < 0) return;
    KArgs a{};
    for (int i = 0; i < 21; ++i) a.p.in[i] = (const float*)d_in[i];
    a.p.out = (float*)d_out; a.p.ws = (unsigned char*)d_ws;
#if MK_SINGLE
    a.ph_lo = 0; a.ph_hi = N_PHASES;
    void* args[] = {&a};
    hipError_t e = hipLaunchCooperativeKernel((const void*)mk_fwd, dim3(grid), dim3(NTHREADS), args, LDS_BYTES, stream);
    if (e != hipSuccess) fprintf(stderr, "kernel_launch: cooperative launch failed: %s (grid %d)\n", hipGetErrorString(e), grid);
#else
#ifndef HOSTDUP
#define HOSTDUP -1
#endif
    for (int k = 0; k < N_PHASES; ++k) { a.ph_lo = k; a.ph_hi = k + 1;
        hipLaunchKernelGGL(mk_fwd, dim3(grid), dim3(NTHREADS), LDS_BYTES, stream, a); }
#endif
}
```

```cpp
#include <hip/hip_runtime.h>
#include <hip/hip_cooperative_groups.h>
#include <cstdio>
#include <cstdint>
namespace cg = cooperative_groups;
namespace pg8 {
#define PG8_LAS __attribute__((address_space(3)))
typedef unsigned short bf16_t;
typedef short bf16x8 __attribute__((ext_vector_type(8)));
typedef float f32x4 __attribute__((ext_vector_type(4)));
typedef unsigned u32x4 __attribute__((ext_vector_type(4)));
constexpr int BM = 256, BK = 64, HALF = 128, HTB = HALF * BK * 2  , STAGE_BYTES = 8 * HTB, NXCD = 8, WGM = 8;

__host__ __device__ __forceinline__ int lds_byte(int r, int c) { const int st = (r >> 4) * 2 + (c >> 5), rr = r & 15, cc = c & 31, ob = rr * 64 + cc * 2; return st * 1024 + (ob ^ (((ob >> 9) & 1) << 5)); }
__host__ __device__ __forceinline__ void stage_rc(int b, int& R, int& C) { const int st = b / 1024, sb = b % 1024, swz = sb ^ (((sb >> 9) & 1) << 5); R = (st >> 1) * 16 + swz / 64; C = (st & 1) * 32 + (swz % 64) / 2; }
__host__ __device__ __forceinline__ int perm32(int rho) { const int n = rho >> 4, i = rho & 15; return 8 * (i >> 2) + 4 * n + (i & 3); }

struct Unit { int pm, pn; };
struct Gemm { const bf16_t* A; const bf16_t* Bt; int M, N, K; };

struct StaticOrder {
    int nM, nN, nwg, G, c;
    __host__ __device__ void init(int M, int N, int G_, int c_) { nM = M / BM; nN = N / BM; nwg = nM * nN; G = G_; c = c_; }
    __host__ __device__ bool next(int i, Unit& u) const {
        const long L = (long)i * G + c; if (L >= nwg) return false;
        int wgid = (int)L; { const int q = nwg / NXCD, r = nwg % NXCD, xcd = wgid % NXCD, off = wgid / NXCD; wgid = (xcd < r ? xcd * (q + 1) : r * (q + 1) + (xcd - r) * q) + off; }
        const int nig = WGM * nN, gid = wgid / nig, fm = gid * WGM, gsz = (nM - fm) < WGM ? (nM - fm) : WGM;
        u.pm = fm + ((wgid % nig) % gsz); u.pn = (wgid % nig) / gsz; return true;
    }
    __device__ __forceinline__ void a_ready(const Unit&) const {}
    __device__ __forceinline__ void done(const Unit&) const {}
};

__device__ __forceinline__ unsigned cvt_pk_bf16(float lo, float hi) { unsigned r; asm volatile("v_cvt_pk_bf16_f32 %0, %1, %2" : "=v"(r) : "v"(lo), "v"(hi)); return r; }
typedef float f32x2 __attribute__((ext_vector_type(2)));
template <class Epi, class Sched, bool ALIGN_EPI = false, bool SP2 = false>
__device__ __forceinline__ void gemm_phase(PG8_LAS unsigned char* lds, const Gemm g, const Sched& S, const Epi& E) {
    const int tid = threadIdx.x, wid = __builtin_amdgcn_readfirstlane(tid >> 6), lane = tid & 63, wr = wid >> 2, wc = wid & 3, fr = lane & 15, fq = lane >> 4;
    const int K = g.K, nt = K / BK;
    unsigned voffA[2], voffB[2];
#pragma unroll
    for (int i = 0; i < 2; ++i) { int R, C; stage_rc(tid * 16 + i * 8192, R, C); const int Rb = Epi::PERM ? ((R & ~31) + perm32(R & 31)) : R;
        voffA[i] = (unsigned)(R * K + C) * 2u; voffB[i] = (unsigned)(Rb * K + C) * 2u; }
    const size_t kstep = (size_t)(BK * 2);
    const size_t hstep = (size_t)HALF * K * 2;
    const size_t tstep = 2 * hstep;
    const unsigned ldsw = (unsigned)wid * 1024u;
    const int aoff = lds_byte(wr * 64 + fr, fq * 8), boff = lds_byte(wc * 32 + fr, fq * 8);
#define PG8_SA(b, h) (((b) * 2 + (h)) * HTB)
#define PG8_SB(b, h) ((4 + (b) * 2 + (h)) * HTB)
#define PG8_STAGE(bufoff, gbase, voff) do { _Pragma("unroll") for (int _i = 0; _i < 2; ++_i) \
        __builtin_amdgcn_global_load_lds((const unsigned*)((const char*)(gbase) + (voff)[_i]), (PG8_LAS unsigned*)(lds + (bufoff) + ldsw + _i * 8192), 16, 0, 0); } while (0)
#define PG8_LDA(dst, b, h) do { _Pragma("unroll") for (int m = 0; m < 4; ++m) _Pragma("unroll") for (int k = 0; k < 2; ++k) dst[m][k] = *(const PG8_LAS bf16x8*)(lds + PG8_SA(b, h) + aoff + m * 2048 + k * 1024); } while (0)
#define PG8_LDB(dst, b, h) do { _Pragma("unroll") for (int n = 0; n < 2; ++n) _Pragma("unroll") for (int k = 0; k < 2; ++k) dst[n][k] = *(const PG8_LAS bf16x8*)(lds + PG8_SB(b, h) + boff + n * 2048 + k * 1024); } while (0)
#define PG8_MMA(ai, bj, At, Bt) do { __builtin_amdgcn_s_setprio(1); _Pragma("unroll") for (int m = 0; m < 4; ++m) _Pragma("unroll") for (int n = 0; n < 2; ++n) _Pragma("unroll") for (int k = 0; k < 2; ++k) \
        acc[ai][bj][m][n] = __builtin_amdgcn_mfma_f32_16x16x32_bf16(Bt[n][k], At[m][k], acc[ai][bj][m][n], 0, 0, 0); __builtin_amdgcn_s_setprio(0); } while (0)
#define PG8_WAIT_V(n) asm volatile("s_waitcnt vmcnt(" #n ")" ::: "memory")
#define PG8_WAIT_L(n) asm volatile("s_waitcnt lgkmcnt(" #n ")" ::: "memory")
#define PG8_BAR __builtin_amdgcn_s_barrier()
#define PG8_SCHED __builtin_amdgcn_sched_barrier(0)
    Unit cur, nxt; int ui = 0;
    if (!S.next(0, cur)) return;
    f32x4 acc[2][2][4][2];
#pragma unroll
    for (int a = 0; a < 2; ++a)
#pragma unroll
        for (int b = 0; b < 2; ++b)
#pragma unroll
            for (int m = 0; m < 4; ++m)
#pragma unroll
                for (int n = 0; n < 2; ++n) acc[a][b][m][n] = (f32x4){0.f, 0.f, 0.f, 0.f};
    bf16x8 At[4][2], B0[2][2], B1[2][2];
    const char* cA = (const char*)g.A + (size_t)cur.pm * tstep; const char* cB = (const char*)g.Bt + (size_t)cur.pn * tstep;
    S.a_ready(cur);
    if constexpr (SP2) {
        PG8_STAGE(PG8_SB(0, 0), cB, voffB); PG8_STAGE(PG8_SB(0, 1), cB + hstep, voffB); PG8_STAGE(PG8_SA(0, 0), cA, voffA); PG8_STAGE(PG8_SA(0, 1), cA + hstep, voffA);
        if (wr == 1) PG8_BAR;
        PG8_WAIT_V(2); PG8_BAR;
        PG8_STAGE(PG8_SB(1, 0), cB + kstep, voffB); PG8_STAGE(PG8_SA(1, 0), cA + kstep, voffA); PG8_STAGE(PG8_SB(1, 1), cB + hstep + kstep, voffB);
        PG8_WAIT_V(6); PG8_BAR;
    } else {
        PG8_STAGE(PG8_SB(0, 0), cB, voffB); PG8_STAGE(PG8_SA(0, 0), cA, voffA); PG8_STAGE(PG8_SB(0, 1), cB + hstep, voffB); PG8_STAGE(PG8_SA(0, 1), cA + hstep, voffA);
        if (wr == 1) PG8_BAR;
        PG8_WAIT_V(4); PG8_BAR;
        PG8_STAGE(PG8_SB(1, 0), cB + kstep, voffB); PG8_STAGE(PG8_SA(1, 0), cA + kstep, voffA); PG8_STAGE(PG8_SB(1, 1), cB + hstep + kstep, voffB);
        PG8_WAIT_V(6); PG8_BAR;
    }
    for (;;) {
        const bool has_next = S.next(ui + 1, nxt);
        const char* nA = has_next ? (const char*)g.A + (size_t)nxt.pm * tstep : cA; const char* nB = has_next ? (const char*)g.Bt + (size_t)nxt.pn * tstep : cB;
        for (int t = 0; t < nt; t += 2) {
            const bool last = (t == nt - 2);
            const char* a1 = cA + (size_t)(t + 1) * kstep;
            const char* a2 = last ? nA : cA + (size_t)(t + 2) * kstep; const char* b2 = last ? nB : cB + (size_t)(t + 2) * kstep;
            const char* a3 = a2 + kstep; const char* b3 = b2 + kstep;
            if (last && has_next) S.a_ready(nxt);
            if constexpr (SP2) {
            PG8_LDB(B0, 0, 0); PG8_LDB(B1, 0, 1); PG8_SCHED; PG8_LDA(At, 0, 0); PG8_STAGE(PG8_SA(1, 1), a1 + hstep, voffA);
            PG8_WAIT_V(8); PG8_WAIT_L(0); PG8_BAR; PG8_MMA(0, 0, At, B0); PG8_MMA(0, 1, At, B1); PG8_BAR; PG8_SCHED;
            PG8_LDA(At, 0, 1); PG8_STAGE(PG8_SB(0, 0), b2, voffB); PG8_STAGE(PG8_SB(0, 1), b2 + hstep, voffB); PG8_STAGE(PG8_SA(0, 0), a2, voffA);
            PG8_WAIT_V(8); PG8_WAIT_L(0); PG8_BAR; PG8_MMA(1, 0, At, B0); PG8_MMA(1, 1, At, B1); PG8_BAR; PG8_SCHED;
            PG8_LDB(B0, 1, 0); PG8_LDB(B1, 1, 1); PG8_SCHED; PG8_LDA(At, 1, 0); PG8_STAGE(PG8_SA(0, 1), a2 + hstep, voffA);
            PG8_WAIT_V(8); PG8_WAIT_L(0); PG8_BAR; PG8_MMA(0, 0, At, B0); PG8_MMA(0, 1, At, B1); PG8_BAR; PG8_SCHED;
            PG8_LDA(At, 1, 1); PG8_STAGE(PG8_SB(1, 0), b3, voffB); PG8_STAGE(PG8_SB(1, 1), b3 + hstep, voffB); PG8_STAGE(PG8_SA(1, 0), a3, voffA);
            PG8_WAIT_V(8); PG8_WAIT_L(0); PG8_BAR; PG8_MMA(1, 0, At, B0); PG8_MMA(1, 1, At, B1); PG8_BAR; PG8_SCHED;
            } else {
            PG8_LDB(B0, 0, 0); PG8_SCHED; PG8_LDA(At, 0, 0); PG8_STAGE(PG8_SA(1, 1), a1 + hstep, voffA);
            PG8_WAIT_L(8); PG8_BAR; PG8_WAIT_L(0); PG8_MMA(0, 0, At, B0); PG8_BAR; PG8_SCHED;
            PG8_LDB(B1, 0, 1); PG8_STAGE(PG8_SB(0, 0), b2, voffB);
            PG8_BAR; PG8_WAIT_L(0); PG8_MMA(0, 1, At, B1); PG8_BAR;
            PG8_LDA(At, 0, 1); PG8_STAGE(PG8_SA(0, 0), a2, voffA);
            PG8_BAR; PG8_WAIT_L(0); PG8_MMA(1, 0, At, B0); PG8_BAR; PG8_SCHED;
            PG8_STAGE(PG8_SB(0, 1), b2 + hstep, voffB);
            PG8_WAIT_V(6); PG8_BAR; PG8_MMA(1, 1, At, B1); PG8_BAR;
            PG8_LDB(B0, 1, 0); PG8_SCHED; PG8_LDA(At, 1, 0); PG8_STAGE(PG8_SA(0, 1), a2 + hstep, voffA);
            PG8_WAIT_L(8); PG8_BAR; PG8_WAIT_L(0); PG8_MMA(0, 0, At, B0); PG8_BAR; PG8_SCHED;
            PG8_LDB(B1, 1, 1); PG8_STAGE(PG8_SB(1, 0), b3, voffB);
            PG8_BAR; PG8_WAIT_L(0); PG8_MMA(0, 1, At, B1); PG8_BAR;
            PG8_LDA(At, 1, 1); PG8_STAGE(PG8_SA(1, 0), a3, voffA);
            PG8_BAR; PG8_WAIT_L(0); PG8_MMA(1, 0, At, B0); PG8_BAR; PG8_SCHED;
            PG8_STAGE(PG8_SB(1, 1), b3 + hstep, voffB);
            PG8_WAIT_V(6); PG8_BAR; PG8_MMA(1, 1, At, B1); PG8_BAR;
            }
        }
        if constexpr (ALIGN_EPI) { if (wr == 0) PG8_BAR; }
        if constexpr (!Epi::AFTER_DRAIN) { E(acc, cur, wr, wc, fr, fq); S.done(cur); }
        if (!has_next) break;
#pragma unroll
        for (int a = 0; a < 2; ++a)
#pragma unroll
            for (int b = 0; b < 2; ++b)
#pragma unroll
                for (int m = 0; m < 4; ++m)
#pragma unroll
                    for (int n = 0; n < 2; ++n) acc[a][b][m][n] = (f32x4){0.f, 0.f, 0.f, 0.f};
        cur = nxt; cA = nA; cB = nB; ++ui;
        if constexpr (ALIGN_EPI) { if (wr == 1) PG8_BAR; }
    }
    PG8_WAIT_V(0);
    if constexpr (!ALIGN_EPI) { if (wr == 0) PG8_BAR; }
    PG8_BAR;
    if constexpr (Epi::AFTER_DRAIN) { E.fused(acc, cur, wr, wc, fr, fq, lds, wid, lane); S.done(cur); }
#undef PG8_SA
#undef PG8_SB
#undef PG8_STAGE
#undef PG8_LDA
#undef PG8_LDB
#undef PG8_MMA
#undef PG8_WAIT_V
#undef PG8_WAIT_L
#undef PG8_BAR
#undef PG8_SCHED
}
}

#define LAS __attribute__((address_space(3)))
typedef unsigned short bf16_t;
typedef short bf16x8 __attribute__((ext_vector_type(8)));
typedef short s16x4 __attribute__((ext_vector_type(4)));
typedef short v4i16_t __attribute__((ext_vector_type(4)));
typedef float f32x4 __attribute__((ext_vector_type(4)));
typedef float f32x2 __attribute__((ext_vector_type(2)));
typedef float f32x16 __attribute__((ext_vector_type(16)));
typedef unsigned u32x4 __attribute__((ext_vector_type(4)));
typedef unsigned u32x2 __attribute__((ext_vector_type(2)));
typedef __bf16 bf16x2_t __attribute__((ext_vector_type(2)));

constexpr int NTHREADS = 512, NWAVES = 8;
constexpr int DM = 1024, NPR = 8192, MROWS = 40960, KVROWS = 45056;
constexpr size_t MiB = 1u << 20;
constexpr size_t WS_W_EIN = 0, WS_W_EOUT = 8 * MiB, WS_W_OIN = 10 * MiB, WS_W_QUP = 14 * MiB, WS_W_KVUP = 16 * MiB, WS_W_OOUT = 17 * MiB;
constexpr size_t WS_MOD = 19 * MiB, WS_TAB = 19 * MiB + 512 * 1024, WS_BAR = 19 * MiB + 768 * 1024, WS_ACT = 20 * MiB, WS_P = 100 * MiB, WS_ST = 420 * MiB, WS_END = 500 * MiB;
constexpr size_t WS_QN = WS_ACT, WS_CKV = WS_ACT + 32 * MiB, WS_KR = WS_ACT + 56 * MiB;
constexpr size_t WS_LATQ = WS_P, WS_GATE = WS_P + 120 * MiB, WS_KV = WS_P + 200 * MiB, WS_LAT16 = WS_KV, WS_X2B = WS_KV;
constexpr size_t OFF_SF = 41943040, OFF_SB = OFF_SF + 2097152, OFF_CKV = OFF_SB + 2097152, OFF_KR = OFF_CKV + 2097152, OUT_TOTAL = OFF_KR + 524288;
constexpr int LDS_BYTES = 147456;
constexpr int PP = 3072;
constexpr float EPS = 1e-6f;

struct Params { const float* in[21]; float* out; unsigned char* ws; };
enum { I_XP = 0, I_XS, I_C, I_SRF, I_SRB, I_CCKV, I_CKR, I_CCTX, I_ADAW, I_ADAB, I_NORMG, I_EINW, I_CONVW, I_EOUTW, I_OINW, I_QNG, I_KVNG, I_QUPW, I_KVUPW, I_OOUTW, I_FING };

__device__ __forceinline__ unsigned cvtpk(float lo, float hi) { f32x2 v = {lo, hi}; bf16x2_t b = __builtin_convertvector(v, bf16x2_t); return __builtin_bit_cast(unsigned, b); }
__device__ __forceinline__ bf16_t f2bf(float x) { return (bf16_t)(cvtpk(x, 0.f) & 0xffffu); }
__device__ __forceinline__ float bflo(unsigned w) { return __uint_as_float(w << 16); }
__device__ __forceinline__ float bfhi(unsigned w) { return __uint_as_float(w & 0xffff0000u); }
__device__ __forceinline__ float silu_f(float v) { return v * __builtin_amdgcn_rcpf(1.f + __builtin_amdgcn_exp2f(-1.4426950408889634f * v)); }
__device__ __forceinline__ float wave_sum(float v) {
#pragma unroll
    for (int o = 1; o < 64; o <<= 1) v += __shfl_xor(v, o);
    return v;
}
__device__ __forceinline__ int crow(int r, int hi) { return (r & 3) + 8 * (r >> 2) + 4 * hi; }
__device__ __forceinline__ unsigned off_b(unsigned row, unsigned ch) { return 256u * row + 16u * (ch ^ (((row & 3) << 2) | ((row >> 2) & 3))); }
__device__ __forceinline__ s16x4 vtr(LAS const char* p) { return __builtin_bit_cast(s16x4, __builtin_amdgcn_ds_read_tr16_b64_v4i16((LAS v4i16_t*)p)); }
__device__ __forceinline__ bf16x8 mk8(s16x4 lo, s16x4 hi) { return __builtin_shufflevector(lo, hi, 0, 1, 2, 3, 4, 5, 6, 7); }
#define MFMA32(a, b, c) __builtin_amdgcn_mfma_f32_32x32x16_bf16((a), (b), (c), 0, 0, 0)

namespace pg8 {
struct EpiBf16S {
    static constexpr bool PERM = true, AFTER_DRAIN = false;
    bf16_t* O; int ldc; int s_lo, s_hi; float sc; int o2_from; bf16_t* O2; int ldc2;
    int pair_from;
    int pair_col0;
    __device__ __forceinline__ void operator()(const f32x4 (&acc)[2][2][4][2], const Unit& u, int wr, int wc, int fr, int fq) const {
        const int row0 = u.pm * BM + wr * 64 + fr;
        if (u.pn >= pair_from) {
            const bool gated = u.pn >= pair_from + 4;
            const int col0 = pair_col0 + (u.pn - pair_from) * (BM / 2) + wc * 16 + 4 * fq;
#pragma unroll
            for (int ai = 0; ai < 2; ++ai)
#pragma unroll
                for (int m = 0; m < 4; ++m) { bf16_t* rowp = O + (size_t)(row0 + ai * HALF + m * 16) * ldc + col0;
#pragma unroll
                    for (int bj = 0; bj < 2; ++bj) { const f32x4 a0 = acc[ai][bj][m][0]; f32x4 a1 = acc[ai][bj][m][1];
                        if (gated) { a1[0] = ::silu_f(a1[0]); a1[1] = ::silu_f(a1[1]); a1[2] = ::silu_f(a1[2]); a1[3] = ::silu_f(a1[3]); }
                        const f32x4 v = a0 * a1; u32x2 w; w.x = ::cvtpk(v[0], v[1]); w.y = ::cvtpk(v[2], v[3]);
                        *(u32x2*)(rowp + bj * (HALF / 2)) = w; } }
            return;
        }
        const bool second = u.pn >= o2_from;
        bf16_t* base = second ? O2 : O; const int ld = second ? ldc2 : ldc;
        const float s = (u.pn >= s_lo && u.pn < s_hi) ? sc : 1.f;
        const int col0 = (second ? u.pn - o2_from : u.pn) * BM + wc * 32 + 8 * fq;
#pragma unroll
        for (int ai = 0; ai < 2; ++ai)
#pragma unroll
            for (int m = 0; m < 4; ++m) { bf16_t* rowp = base + (size_t)(row0 + ai * HALF + m * 16) * ld + col0;
#pragma unroll
                for (int bj = 0; bj < 2; ++bj) { const f32x4 v0 = acc[ai][bj][m][0] * s, v1 = acc[ai][bj][m][1] * s;
                    u32x4 w; w.x = ::cvtpk(v0[0], v0[1]); w.y = ::cvtpk(v0[2], v0[3]); w.z = ::cvtpk(v1[0], v1[1]); w.w = ::cvtpk(v1[2], v1[3]);
                    *(u32x4*)(rowp + bj * HALF) = w; } }
    }
};
struct EpiRes {
    static constexpr bool PERM = false, AFTER_DRAIN = false;
    const float* xp; const float* xs; const bf16_t* B16; bf16_t* O16; const float* modl; int pm0;
    __device__ __forceinline__ void operator()(const f32x4 (&acc)[2][2][4][2], const Unit& u, int wr, int wc, int fr, int fq) const {
        const int pma = u.pm + pm0; const int r = pma < 32 ? 8 : ((pma - 32) >> 4);
        const float* gate = modl + r * 3072 + 2048;
        const int col0 = u.pn * BM + wc * 32 + 4 * fq;
        f32x4 gv[2][2];
#pragma unroll
        for (int bj = 0; bj < 2; ++bj)
#pragma unroll
            for (int n = 0; n < 2; ++n) gv[bj][n] = *(const f32x4*)(gate + col0 + bj * HALF + n * 16);
#pragma unroll
        for (int ai = 0; ai < 2; ++ai)
#pragma unroll
            for (int m = 0; m < 4; ++m) { const int row = pma * BM + ai * HALF + wr * 64 + m * 16 + fr;
                const float* xr = (row < 8192) ? xp + (size_t)row * 1024 : xs + (size_t)(row - 8192) * 1024;
#pragma unroll
                for (int bj = 0; bj < 2; ++bj)
#pragma unroll
                    for (int n = 0; n < 2; ++n) { const int c = col0 + bj * HALF + n * 16; f32x4 xv;
                        if (B16) { const u32x2 w = *(const u32x2*)(B16 + (size_t)row * 1024 + c); xv = (f32x4){::bflo(w.x), ::bfhi(w.x), ::bflo(w.y), ::bfhi(w.y)}; }
                        else xv = __builtin_nontemporal_load((const f32x4*)(xr + c));
                        const f32x4 o = xv + gv[bj][n] * acc[ai][bj][m][n];
                        u32x2 w2; w2.x = ::cvtpk(o[0], o[1]); w2.y = ::cvtpk(o[2], o[3]); *(u32x2*)(O16 + (size_t)row * 1024 + c) = w2; } }
    }
};
struct EpiQ {
    static constexpr bool PERM = false, AFTER_DRAIN = false;
    bf16_t* O; const f32x2* tab;
    __device__ __forceinline__ void operator()(const f32x4 (&acc)[2][2][4][2], const Unit& u, int wr, int wc, int fr, int fq) const {
        const bool rope = u.pm >= 32;
        const int col0 = u.pn * BM + wc * 32 + 4 * fq;
#pragma unroll
        for (int ai = 0; ai < 2; ++ai)
#pragma unroll
            for (int m = 0; m < 4; ++m) { const int row = u.pm * BM + ai * HALF + wr * 64 + m * 16 + fr; const int t = (row - 8192) & 4095;
                bf16_t* rowp = O + (size_t)row * 1536 + col0;
#pragma unroll
                for (int bj = 0; bj < 2; ++bj) { f32x4 v0 = acc[ai][bj][m][0], v1 = acc[ai][bj][m][1];
                    const int g = 8 * u.pn + 4 * bj + wc, gh = g % 6;
                    if (rope && gh >= 4) { const int pos = (gh == 4) ? (t >> 6) : (t & 63); const f32x2* tp = tab + pos * 16 + 4 * fq;
#pragma unroll
                        for (int e = 0; e < 4; ++e) { const f32x2 cs = tp[e]; const float x1 = v0[e], x2 = v1[e]; v0[e] = x1 * cs.x - x2 * cs.y; v1[e] = x1 * cs.y + x2 * cs.x; } }
                    u32x2 w0, w1; w0.x = ::cvtpk(v0[0], v0[1]); w0.y = ::cvtpk(v0[2], v0[3]); w1.x = ::cvtpk(v1[0], v1[1]); w1.y = ::cvtpk(v1[2], v1[3]);
                    *(u32x2*)(rowp + bj * HALF) = w0; *(u32x2*)(rowp + bj * HALF + 16) = w1; }
                asm volatile("" ::: "memory"); }
    }
};
}

__device__ __forceinline__ int ein_row(int n) {
    if (n < 2048) return n;
    const int sec = (n - 2048) >> 9, ch = (n - 2048) & 511, g8 = 8 * (ch >> 2) + (ch & 3);
    return sec == 0 ? 3072 + g8 : sec == 1 ? 2048 + g8 : sec == 2 ? 2048 + g8 + 4 : 3072 + g8 + 4;
}
__device__ __forceinline__ void transpose_item(const float* __restrict__ W, int K, int N, bf16_t* WT, int k0, int n0, int drow0, LAS float* scr, int lane, int kind = 0) {
#pragma unroll 8
    for (int i = 0; i < 32; ++i) { const int kk = 2 * i + (lane >> 5); scr[kk * 33 + (lane & 31)] = __builtin_nontemporal_load(W + (size_t)(k0 + kk) * N + n0 + (lane & 31)); }
    asm volatile("s_waitcnt lgkmcnt(0)" ::: "memory");
    const int c = lane & 7;
#pragma unroll
    for (int j = 0; j < 4; ++j) { const int n = (lane >> 3) + 8 * j; const LAS float* s = scr + (8 * c) * 33 + n;
        u32x4 o; o.x = cvtpk(s[0 * 33], s[1 * 33]); o.y = cvtpk(s[2 * 33], s[3 * 33]); o.z = cvtpk(s[4 * 33], s[5 * 33]); o.w = cvtpk(s[6 * 33], s[7 * 33]);
        *(u32x4*)(WT + (size_t)(kind ? ein_row(n0 + n) : drow0 + n) * K + k0 + 8 * c) = o; }
    asm volatile("s_waitcnt lgkmcnt(0)" ::: "memory");
}

__device__ __forceinline__ void p0_phase(const Params& p, LAS char* L, int G) {
    const int tid = threadIdx.x, lane = tid & 63, wave = tid >> 6;
    unsigned char* ws = p.ws;
    float* mod = (float*)(ws + WS_MOD);
    if ((int)blockIdx.x < 192) {
        LAS float* sil = (LAS float*)L; LAS float* red = (LAS float*)(L + 36864);
        for (int i = tid; i < 9216; i += NTHREADS) { const int r = i >> 10, k = i & 1023; const float v = r < 8 ? p.in[I_C][r * 1024 + k] : p.in[I_CCTX][k]; sil[i] = v / (1.f + expf(-v)); }
        __syncthreads();
        for (int it = blockIdx.x; it < 192; it += G) {
            const int l = it / 96, n0 = (it % 96) * 32, col = lane & 31, ksub = lane >> 5;
            const float* Wl = p.in[I_ADAW] + (size_t)l * 1024 * 3072 + n0 + col;
            float a[9];
#pragma unroll
            for (int r = 0; r < 9; ++r) a[r] = 0.f;
#pragma unroll 8
            for (int i = 0; i < 64; ++i) { const int k = 128 * wave + 2 * i + ksub; const float w = __builtin_nontemporal_load(Wl + (size_t)k * 3072);
#pragma unroll
                for (int r = 0; r < 9; ++r) a[r] += sil[r * 1024 + k] * w; }
#pragma unroll
            for (int r = 0; r < 9; ++r) { a[r] += __shfl_xor(a[r], 32); if (ksub == 0) red[(wave * 9 + r) * 32 + col] = a[r]; }
            __syncthreads();
            if (tid < 288) { const int r = tid >> 5, cc = tid & 31; float s = p.in[I_ADAB][l * 3072 + n0 + cc];
#pragma unroll
                for (int w = 0; w < 8; ++w) s += red[(w * 9 + r) * 32 + cc];
                mod[(size_t)(l * 9 + r) * 3072 + n0 + cc] = s; }
            __syncthreads();
        }
    }
    { const int gt = blockIdx.x * NTHREADS + tid;
      if (gt < 1024) { const int pos = gt >> 4, fi = gt & 15; const float inv = exp2f(-(float)fi * (13.287712379549449f / 16.f)); const float ang = (float)pos * inv;
          float rev = ang * 0.15915494309189535f; rev -= floorf(rev);
          ((f32x2*)(ws + WS_TAB))[gt] = (f32x2){__builtin_amdgcn_cosf(rev), __builtin_amdgcn_sinf(rev)}; } }
    { const int gt = blockIdx.x * NTHREADS + tid; u32x4* z = (u32x4*)(ws + WS_W_OIN + (size_t)1728 * 1024 * 2);
      for (int i = gt; i < 64 * 1024 * 2 / 16; i += G * NTHREADS) z[i] = (u32x4){0u, 0u, 0u, 0u}; }
    LAS float* scr = (LAS float*)(L + 49152 + wave * 8448);
    const int gw = blockIdx.x * NWAVES + wave, NGW = G * NWAVES;
    constexpr int I0 = 16 * 128, I1 = 16 * 32, I2 = 16 * 54, I3 = 6 * 48, I4 = 4 * 64, I5 = 16 * 32, NIT = I0 + I1 + I2 + I3 + I4 + I5;
    for (int it = gw; it < NIT; it += NGW) {
        int r = it;
        if (r < I0) { const int nb = r % 128, kb = r / 128; transpose_item(p.in[I_EINW], 1024, 4096, (bf16_t*)(ws + WS_W_EIN), kb * 64, nb * 32, nb * 32, scr, lane, 1); continue; } r -= I0;
        if (r < I1) { const int nb = r % 32, kb = r / 32; transpose_item(p.in[I_EOUTW], 1024, 1024, (bf16_t*)(ws + WS_W_EOUT), kb * 64, nb * 32, nb * 32, scr, lane); continue; } r -= I1;
        if (r < I2) { const int nb = r % 54, kb = r / 54, n0 = nb * 32; const int d0 = n0 < 704 ? n0 + 1024 : n0 - 704;
            transpose_item(p.in[I_OINW], 1024, 1728, (bf16_t*)(ws + WS_W_OIN), kb * 64, n0, d0, scr, lane); continue; } r -= I2;
        if (r < I3) { const int nb = r % 48, kb = r / 48; transpose_item(p.in[I_QUPW], 384, 1536, (bf16_t*)(ws + WS_W_QUP), kb * 64, nb * 32, nb * 32, scr, lane); continue; } r -= I3;
        if (r < I4) { const int nb = r % 64, kb = r / 64; transpose_item(p.in[I_KVUPW], 256, 2048, (bf16_t*)(ws + WS_W_KVUP), kb * 64, nb * 32, nb * 32, scr, lane); continue; } r -= I4;
        { const int nb = r % 32, kb = r / 32; transpose_item(p.in[I_OOUTW], 1024, 1024, (bf16_t*)(ws + WS_W_OOUT), kb * 64, nb * 32, nb * 32, scr, lane); }
    }
}

__device__ __forceinline__ f32x4 ld_row4(const float* xf, const bf16_t* x16, size_t off) {
    if (x16) { const u32x2 w = *(const u32x2*)(x16 + off); return (f32x4){bflo(w.x), bfhi(w.x), bflo(w.y), bfhi(w.y)}; }
    return __builtin_nontemporal_load((const f32x4*)(xf + off));
}
__device__ __forceinline__ void norm_mod_phase(const float* xp, const float* xs, const bf16_t* x16, const float* g, const float* modl, bf16_t* H, int gwb, int nwb, int lo0, int hi0, int lo1, int hi1) {
    const int lane = threadIdx.x & 63, wave = threadIdx.x >> 6;
    const int gw = gwb * NWAVES + wave, NGW = nwb * NWAVES, n0_ = hi0 - lo0, total = n0_ + (hi1 - lo1);
    f32x4 gv[4];
#pragma unroll
    for (int j = 0; j < 4; ++j) gv[j] = *(const f32x4*)(g + 4 * lane + 256 * j);
    for (int i0 = gw; i0 < total; i0 += 2 * NGW) {
        const bool has1 = i0 + NGW < total; const int i1 = has1 ? i0 + NGW : i0;
        const int m0 = i0 < n0_ ? lo0 + i0 : lo1 + (i0 - n0_), m1 = i1 < n0_ ? lo0 + i1 : lo1 + (i1 - n0_);
        const float* xf0 = x16 ? nullptr : ((m0 < NPR) ? xp + (size_t)m0 * DM : xs + (size_t)(m0 - NPR) * DM);
        const float* xf1 = x16 ? nullptr : ((m1 < NPR) ? xp + (size_t)m1 * DM : xs + (size_t)(m1 - NPR) * DM);
        const bf16_t* xb0 = x16 ? x16 + (size_t)m0 * DM : nullptr; const bf16_t* xb1 = x16 ? x16 + (size_t)m1 * DM : nullptr;
        const float* md0 = modl + ((m0 < NPR) ? 8 : ((m0 - NPR) >> 12)) * 3072; const float* md1 = modl + ((m1 < NPR) ? 8 : ((m1 - NPR) >> 12)) * 3072;
        f32x4 v0[4], v1[4], sc0[4], sh0[4], sc1[4], sh1[4];
#pragma unroll
        for (int j = 0; j < 4; ++j) { const int c = 4 * lane + 256 * j; v0[j] = ld_row4(xf0, xb0, c); v1[j] = ld_row4(xf1, xb1, c); }
#pragma unroll
        for (int j = 0; j < 4; ++j) { const int c = 4 * lane + 256 * j; sh0[j] = *(const f32x4*)(md0 + c); sc0[j] = *(const f32x4*)(md0 + 1024 + c); sh1[j] = *(const f32x4*)(md1 + c); sc1[j] = *(const f32x4*)(md1 + 1024 + c); }
        float s0 = 0.f, s1 = 0.f;
#pragma unroll
        for (int j = 0; j < 4; ++j) { s0 += (v0[j].x * v0[j].x + v0[j].y * v0[j].y) + (v0[j].z * v0[j].z + v0[j].w * v0[j].w); s1 += (v1[j].x * v1[j].x + v1[j].y * v1[j].y) + (v1[j].z * v1[j].z + v1[j].w * v1[j].w); }
#pragma unroll
        for (int o = 1; o < 64; o <<= 1) { s0 += __shfl_xor(s0, o); s1 += __shfl_xor(s1, o); }
        const float r0 = rsqrtf(s0 * (1.f / DM) + EPS), r1 = rsqrtf(s1 * (1.f / DM) + EPS);
#pragma unroll
        for (int j = 0; j < 4; ++j) { const int c = 4 * lane + 256 * j;
            { const f32x4 h = (v0[j] * r0) * gv[j] * (sc0[j] + 1.f) + sh0[j]; u32x2 w; w.x = cvtpk(h.x, h.y); w.y = cvtpk(h.z, h.w); *(u32x2*)(H + (size_t)m0 * DM + c) = w; }
            if (has1) { const f32x4 h = (v1[j] * r1) * gv[j] * (sc1[j] + 1.f) + sh1[j]; u32x2 w; w.x = cvtpk(h.x, h.y); w.y = cvtpk(h.z, h.w); *(u32x2*)(H + (size_t)m1 * DM + c) = w; } }
    }
}

__device__ __forceinline__ void ret_local_phase(const Params& p, LAS char* L, int G) {
    const int tid = threadIdx.x, lane = tid & 63, wave = tid >> 6, h5 = lane >> 5, l31 = lane & 31, dir = wave >> 2, eb = wave & 3;
    const int blk = (lane >> 4) & 1, q = (lane & 15) >> 2, pp = lane & 3;
    const bf16_t* P = (const bf16_t*)(p.ws + WS_P); bf16_t* ST = (bf16_t*)(p.ws + WS_ST);
    LAS char* Vt = L; LAS char* Kt = L + 32768 + dir * 32768;
    const unsigned r0 = 8 * h5 + q, r1 = r0 + 4;
    const unsigned aA0 = off_b(r0, 4 * eb + 2 * blk + (pp >> 1)) + 8 * (pp & 1), aA1 = off_b(r1, 4 * eb + 2 * blk + (pp >> 1)) + 8 * (pp & 1);
    const int njobs = 1024 + 256;
    for (int u = blockIdx.x; u < 1024 + 128; u += G) {
        const bool ctx = u >= 1024; const int v_ = u & 255; const int hh = ctx ? (u & 3) : ((v_ >> 3) & 3);
        const float lgf = log2f(1.f - exp2f(-5.f - (float)hh)), lgb = log2f(1.f - exp2f(-5.5f - (float)hh));
        const float cdec = exp2f(128.f * (dir ? lgb : lgf));
        const int seq = (u - 1024) >> 2;
#pragma unroll 1
        for (int j = 0; j < (ctx ? 2 : 1); ++j) {
            const int gc = ctx ? 2 * seq + j : 64 + (u >> 8) * 64 + (v_ & 7) + 8 * (v_ >> 5);
            const size_t rowbase = (size_t)gc * 128;
            __syncthreads();
#pragma unroll
            for (int i = 0; i < 4; ++i) { const int n = tid + 512 * i, row = n >> 4, ch = n & 15; const bf16_t* gp = P + (rowbase + row) * PP + hh * 128 + ch * 8;
                const u32x4 w = *(const u32x4*)(gp + 512), v = *(const u32x4*)(gp + 1024); const unsigned o = off_b(row, ch);
                const float kf = exp2f(lgf * (float)(127 - row)), kb = exp2f(lgb * (float)row);
                u32x4 a, b;
                a.x = cvtpk(bflo(w.x) * kf, bfhi(w.x) * kf); a.y = cvtpk(bflo(w.y) * kf, bfhi(w.y) * kf); a.z = cvtpk(bflo(w.z) * kf, bfhi(w.z) * kf); a.w = cvtpk(bflo(w.w) * kf, bfhi(w.w) * kf);
                b.x = cvtpk(bflo(w.x) * kb, bfhi(w.x) * kb); b.y = cvtpk(bflo(w.y) * kb, bfhi(w.y) * kb); b.z = cvtpk(bflo(w.z) * kb, bfhi(w.z) * kb); b.w = cvtpk(bflo(w.w) * kb, bfhi(w.w) * kb);
                *(LAS u32x4*)(Vt + o) = v; *(LAS u32x4*)(L + 32768 + o) = a; *(LAS u32x4*)(L + 65536 + o) = b; }
            __syncthreads();
            f32x16 acc[4];
#pragma unroll
            for (int x = 0; x < 4; ++x)
#pragma unroll
                for (int r = 0; r < 16; ++r) acc[x][r] = 0.f;
#pragma unroll 2
            for (int ks = 0; ks < 8; ++ks) {
                const bf16x8 A = mk8(vtr(Vt + aA0 + 4096 * ks), vtr(Vt + aA1 + 4096 * ks));
#pragma unroll
                for (int x = 0; x < 4; ++x) { const unsigned cb = 4 * x + 2 * blk + (pp >> 1);
                    const bf16x8 B = mk8(vtr(Kt + off_b(r0, cb) + 8 * (pp & 1) + 4096 * ks), vtr(Kt + off_b(r1, cb) + 8 * (pp & 1) + 4096 * ks));
                    acc[x] = MFMA32(A, B, acc[x]); }
            }
            bf16_t* own = ST + ((size_t)(gc * 4 + hh) * 2 + dir) * 16384;
            if (!ctx) {
#pragma unroll
                for (int x = 0; x < 4; ++x)
#pragma unroll
                    for (int r = 0; r < 16; ++r) own[(32 * eb + crow(r, h5)) * 128 + 32 * x + l31] = f2bf(acc[x][r]);
            } else {
                const bool first_in_dir = (dir == 0) ? (j == 0) : (j == 1);
                bf16_t* other = ST + ((size_t)((gc ^ 1) * 4 + hh) * 2 + dir) * 16384;
                if (first_in_dir) {
#pragma unroll
                    for (int x = 0; x < 4; ++x)
#pragma unroll
                        for (int r = 0; r < 16; ++r) { const int o = (32 * eb + crow(r, h5)) * 128 + 32 * x + l31; own[o] = 0; other[o] = f2bf(acc[x][r]); }
                }
                float* dst = p.out + (dir ? OFF_SB : OFF_SF) + (size_t)(seq * 4 + hh) * 16384;
                const float sc = first_in_dir ? cdec : 1.f;
#pragma unroll
                for (int x = 0; x < 4; ++x) { const int d = 32 * x + l31;
#pragma unroll
                    for (int rg = 0; rg < 4; ++rg) { float* dp = dst + d * 128 + 32 * eb + 8 * rg + 4 * h5;
                        f32x4 v = (f32x4){acc[x][4 * rg], acc[x][4 * rg + 1], acc[x][4 * rg + 2], acc[x][4 * rg + 3]} * sc;
                        if (j == 1) v += *(const f32x4*)dp;
                        *(f32x4*)dp = v; } }
            }
        }
    }
}
__device__ __forceinline__ void ret_scan2_phase(const Params& p, int G) {
    bf16_t* ST = (bf16_t*)(p.ws + WS_ST);
    for (int it = blockIdx.x * NTHREADS + threadIdx.x; it < 64 * 2048; it += G * NTHREADS) {
        const int chain = it >> 11, b = chain >> 3, hh = (chain >> 1) & 3, dir = chain & 1, e = (it >> 4) & 127, d0 = (it & 15) * 8;
        const float lg = log2f(1.f - exp2f(-5.f - (float)hh - 0.5f * (float)dir)), cdec = exp2f(128.f * lg);
        const float* src = p.in[dir ? I_SRB : I_SRF] + (size_t)(b * 4 + hh) * 16384;
        float S[8];
#pragma unroll
        for (int i = 0; i < 8; ++i) S[i] = src[(d0 + i) * 128 + e];
        bf16_t* base = ST + ((size_t)((64 + b * 32) * 4 + hh) * 2 + dir) * 16384 + e * 128 + d0;
#pragma unroll 1
        for (int kb = 0; kb < 2; ++kb) {
            u32x4 Lr[16];
#pragma unroll
            for (int i = 0; i < 16; ++i) { const int c = dir ? 31 - (kb * 16 + i) : kb * 16 + i; Lr[i] = *(const u32x4*)(base + (size_t)c * 8 * 16384); }
#pragma unroll
            for (int i = 0; i < 16; ++i) { const int c = dir ? 31 - (kb * 16 + i) : kb * 16 + i;
                u32x4 o; o.x = cvtpk(S[0], S[1]); o.y = cvtpk(S[2], S[3]); o.z = cvtpk(S[4], S[5]); o.w = cvtpk(S[6], S[7]);
                *(u32x4*)(base + (size_t)c * 8 * 16384) = o;
                const u32x4 w = Lr[i];
                S[0] = S[0] * cdec + bflo(w.x); S[1] = S[1] * cdec + bfhi(w.x); S[2] = S[2] * cdec + bflo(w.y); S[3] = S[3] * cdec + bfhi(w.y);
                S[4] = S[4] * cdec + bflo(w.z); S[5] = S[5] * cdec + bfhi(w.z); S[6] = S[6] * cdec + bflo(w.w); S[7] = S[7] * cdec + bfhi(w.w); }
        }
    }
}

__device__ __forceinline__ void ret_out_phase(const Params& p, LAS char* L, int G) {
    const int tid = threadIdx.x, lane = tid & 63, wave = tid >> 6, h5 = lane >> 5, blk = (lane >> 4) & 1, q = (lane & 15) >> 2, pp = lane & 3, l31 = lane & 31;
    LAS char* Qt = L; LAS char* Kt = L + 32768; LAS char* Vt = L + 65536; LAS float* ssq = (LAS float*)(L + 98304);
    const bf16_t* P = (const bf16_t*)(p.ws + WS_P); const bf16_t* ST = (const bf16_t*)(p.ws + WS_ST); bf16_t* MIX = (bf16_t*)(p.ws + WS_ACT);
    const float* convw = p.in[I_CONVW];
    const int ib = wave & 3, eh = wave >> 2;
    for (int u = blockIdx.x; u < 1280; u += G) {
        const int v_ = u & 255, hh = (v_ >> 3) & 3, gc = (u >> 8) * 64 + (v_ & 7) + 8 * (v_ >> 5);
        const size_t rowbase = (size_t)gc * 128;
        const int T = gc < 64 ? 256 : 4096, tok0 = gc < 64 ? (gc & 1) * 128 : ((gc - 64) & 31) * 128;
        const float lgf = log2f(1.f - exp2f(-5.f - (float)hh)), lgb = log2f(1.f - exp2f(-5.5f - (float)hh));
        const int i_tok = 32 * ib + l31;
        const bf16_t* stf = ST + ((size_t)gc * 4 + hh) * 2 * 16384; const bf16_t* stb = stf + 16384;
        u32x4 tq[4], tf[4], tb[4], tk[4], tv[4], tg[4];
#pragma unroll
        for (int i = 0; i < 4; ++i) { const int n = tid + 512 * i, row = n >> 4, ch = n & 15; const bf16_t* gp = P + (rowbase + row) * PP + hh * 128 + ch * 8;
            tq[i] = *(const u32x4*)gp; tf[i] = *(const u32x4*)(stf + row * 128 + ch * 8); tb[i] = *(const u32x4*)(stb + row * 128 + ch * 8); }
#pragma unroll
        for (int i = 0; i < 4; ++i) { const int n = tid + 512 * i, row = n >> 4, ch = n & 15; const bf16_t* gp = P + (rowbase + row) * PP + hh * 128 + ch * 8;
            tk[i] = *(const u32x4*)(gp + 512); tv[i] = *(const u32x4*)(gp + 1024); tg[i] = *(const u32x4*)(gp + 1536); }
        __syncthreads();
#pragma unroll
        for (int i = 0; i < 4; ++i) { const int n = tid + 512 * i, row = n >> 4, ch = n & 15; const unsigned o = off_b(row, ch);
            *(LAS u32x4*)(Qt + o) = tq[i]; *(LAS u32x4*)(Kt + o) = tf[i]; *(LAS u32x4*)(Vt + o) = tb[i]; }
        __syncthreads();
        f32x16 o[2];
        {
            f32x16 aF[2], aB[2];
#pragma unroll
            for (int x = 0; x < 2; ++x)
#pragma unroll
                for (int r = 0; r < 16; ++r) { aF[x][r] = 0.f; aB[x][r] = 0.f; }
#pragma unroll
            for (int s = 0; s < 8; ++s) {
                const bf16x8 qf = *(const LAS bf16x8*)(Qt + off_b(i_tok, 2 * s + h5));
#pragma unroll
                for (int x = 0; x < 2; ++x) { const unsigned er = 32 * (2 * eh + x) + l31;
                    const bf16x8 af = *(const LAS bf16x8*)(Kt + off_b(er, 2 * s + h5)), ab = *(const LAS bf16x8*)(Vt + off_b(er, 2 * s + h5));
                    aF[x] = MFMA32(af, qf, aF[x]); aB[x] = MFMA32(ab, qf, aB[x]); }
            }
            const float qdf = exp2f(lgf * (float)(i_tok + 1)), qdb = exp2f(lgb * (float)(128 - i_tok));
#pragma unroll
            for (int x = 0; x < 2; ++x)
#pragma unroll
                for (int r = 0; r < 16; ++r) o[x][r] = qdf * aF[x][r] + qdb * aB[x][r];
        }
        __syncthreads();
#pragma unroll
        for (int i = 0; i < 4; ++i) { const int n = tid + 512 * i, row = n >> 4, ch = n & 15; const unsigned oo = off_b(row, ch);
            *(LAS u32x4*)(Kt + oo) = tk[i]; *(LAS u32x4*)(Vt + oo) = tv[i]; }
        __syncthreads();
#pragma unroll 1
        for (int jb = 0; jb < 4; ++jb) {
            f32x16 pacc;
#pragma unroll
            for (int r = 0; r < 16; ++r) pacc[r] = 0.f;
#pragma unroll
            for (int s = 0; s < 8; ++s) {
                const bf16x8 kf = *(const LAS bf16x8*)(Kt + off_b(32 * jb + l31, 2 * s + h5));
                const bf16x8 qf = *(const LAS bf16x8*)(Qt + off_b(i_tok, 2 * s + h5));
                pacc = MFMA32(kf, qf, pacc);
            }
#pragma unroll
            for (int r = 0; r < 16; ++r) { const int j = 32 * jb + crow(r, h5); const int dij = i_tok - j;
                const float mval = dij > 0 ? exp2f(lgf * (float)dij) : (dij < 0 ? exp2f(lgb * (float)(-dij)) : 2.f);
                pacc[r] *= mval; }
#pragma unroll
            for (int s2 = 0; s2 < 2; ++s2) {
                u32x4 w; w.x = cvtpk(pacc[8 * s2], pacc[8 * s2 + 1]); w.y = cvtpk(pacc[8 * s2 + 2], pacc[8 * s2 + 3]); w.z = cvtpk(pacc[8 * s2 + 4], pacc[8 * s2 + 5]); w.w = cvtpk(pacc[8 * s2 + 6], pacc[8 * s2 + 7]);
                const bf16x8 xs = __builtin_bit_cast(bf16x8, w);
                const unsigned r0 = 32 * jb + 16 * s2 + 4 * h5 + q, r1 = r0 + 8;
#pragma unroll
                for (int x = 0; x < 2; ++x) { const unsigned cb = 4 * (2 * eh + x) + 2 * blk + (pp >> 1);
                    const bf16x8 vf = mk8(vtr(Vt + off_b(r0, cb) + 8 * (pp & 1)), vtr(Vt + off_b(r1, cb) + 8 * (pp & 1)));
                    o[x] = MFMA32(vf, xs, o[x]); }
            }
        }
        float ss = 0.f;
#pragma unroll
        for (int x = 0; x < 2; ++x)
#pragma unroll
            for (int r = 0; r < 16; ++r) ss += o[x][r] * o[x][r];
        ss += __shfl_xor(ss, 32);
        if (h5 == 0) ssq[wave * 32 + l31] = ss;
        __syncthreads();
        ss += ssq[(wave ^ 4) * 32 + l31];
        const float rstd = rsqrtf(ss * (1.f / 128.f) + EPS);
#pragma unroll
        for (int x = 0; x < 2; ++x)
#pragma unroll
            for (int rg = 0; rg < 4; ++rg) { const int e0 = 32 * (2 * eh + x) + 8 * rg + 4 * h5;
                u32x2 w; w.x = cvtpk(o[x][4 * rg] * rstd, o[x][4 * rg + 1] * rstd); w.y = cvtpk(o[x][4 * rg + 2] * rstd, o[x][4 * rg + 3] * rstd);
                *(LAS u32x2*)(Qt + off_b(i_tok, e0 >> 3) + 2 * (e0 & 7)) = w; }
        __syncthreads();
#pragma unroll
        for (int i = 0; i < 4; ++i) { const int n = tid + 512 * i, row = n >> 4, ch = n & 15;
            const u32x4 ov = *(const LAS u32x4*)(Qt + off_b(row, ch)); const u32x4 g = tg[i]; u32x4 w;
            w.x = cvtpk(bflo(ov.x) * silu_f(bflo(g.x)), bfhi(ov.x) * silu_f(bfhi(g.x))); w.y = cvtpk(bflo(ov.y) * silu_f(bflo(g.y)), bfhi(ov.y) * silu_f(bfhi(g.y)));
            w.z = cvtpk(bflo(ov.z) * silu_f(bflo(g.z)), bfhi(ov.z) * silu_f(bfhi(g.z))); w.w = cvtpk(bflo(ov.w) * silu_f(bflo(g.w)), bfhi(ov.w) * silu_f(bfhi(g.w)));
            *(u32x4*)(MIX + (rowbase + row) * 1024 + hh * 128 + ch * 8) = w; }
        { const int c8 = (tid & 15) * 8, tr = tid >> 4, cc = hh * 128 + c8;
          float w0[8], w1[8], w2[8];
#pragma unroll
          for (int e_ = 0; e_ < 8; ++e_) { w0[e_] = convw[cc + e_]; w1[e_] = convw[512 + cc + e_]; w2[e_] = convw[1024 + cc + e_]; }
#pragma unroll 2
          for (int itk = 0; itk < 4; ++itk) { const int tk_ = itk * 32 + tr, pos = tok0 + tk_; const bf16_t* rp = P + (rowbase + tk_) * PP + cc;
              const u32x4 zero4 = (u32x4){0u, 0u, 0u, 0u};
              const u32x4 gb = *(const u32x4*)(rp + 2560), z1 = *(const u32x4*)(rp + 2048);
              const u32x4 z0 = pos > 0 ? *(const u32x4*)(rp - PP + 2048) : zero4, z2 = pos + 1 < T ? *(const u32x4*)(rp + PP + 2048) : zero4;
              float y[8];
#pragma unroll
              for (int e2 = 0; e2 < 4; ++e2) {
                  y[2 * e2] = bflo(gb[e2]) * (bflo(z0[e2]) * w0[2 * e2] + bflo(z1[e2]) * w1[2 * e2] + bflo(z2[e2]) * w2[2 * e2]);
                  y[2 * e2 + 1] = bfhi(gb[e2]) * (bfhi(z0[e2]) * w0[2 * e2 + 1] + bfhi(z1[e2]) * w1[2 * e2 + 1] + bfhi(z2[e2]) * w2[2 * e2 + 1]); }
              u32x4 w; w.x = cvtpk(y[0], y[1]); w.y = cvtpk(y[2], y[3]); w.z = cvtpk(y[4], y[5]); w.w = cvtpk(y[6], y[7]);
              *(u32x4*)(MIX + (rowbase + tk_) * 1024 + 512 + cc) = w; } }
    }
}

__device__ __forceinline__ void lat_phase(const Params& p, int G) {
    const int lane = threadIdx.x & 63, wave = threadIdx.x >> 6;
    const int gw = blockIdx.x * NWAVES + wave, NGW = G * NWAVES;
    const bf16_t* LAT = (const bf16_t*)(p.ws + WS_LAT16); bf16_t* QN = (bf16_t*)(p.ws + WS_QN); bf16_t* CKV = (bf16_t*)(p.ws + WS_CKV); bf16_t* KR = (bf16_t*)(p.ws + WS_KR);
    const f32x2* tab = (const f32x2*)(p.ws + WS_TAB);
    const float* qng = p.in[I_QNG]; const float* kvng = p.in[I_KVNG];
    for (int m = gw; m < KVROWS; m += NGW) {
        if (m < MROWS) {
            const bf16_t* lat = LAT + (size_t)m * 768;
            unsigned qw[3];
#pragma unroll
            for (int j = 0; j < 3; ++j) qw[j] = *(const unsigned*)(lat + 2 * lane + 128 * j);
            const u32x2 kw = *(const u32x2*)(lat + 384 + 4 * lane);
            const float kr = __uint_as_float((unsigned)lat[640 + lane] << 16);
            f32x2 qv[3]; float ssq = 0.f;
#pragma unroll
            for (int j = 0; j < 3; ++j) { qv[j] = (f32x2){bflo(qw[j]), bfhi(qw[j])}; ssq += qv[j].x * qv[j].x + qv[j].y * qv[j].y; }
            const f32x4 kv = (f32x4){bflo(kw.x), bfhi(kw.x), bflo(kw.y), bfhi(kw.y)};
            float ssk = (kv.x * kv.x + kv.y * kv.y) + (kv.z * kv.z + kv.w * kv.w);
#pragma unroll
            for (int o = 1; o < 64; o <<= 1) { ssq += __shfl_xor(ssq, o); ssk += __shfl_xor(ssk, o); }
            { const float rstd = rsqrtf(ssq * (1.f / 384.f) + EPS);
#pragma unroll
              for (int j = 0; j < 3; ++j) { const f32x2 gv = *(const f32x2*)(qng + 2 * lane + 128 * j); *(unsigned*)(QN + (size_t)m * 384 + 2 * lane + 128 * j) = cvtpk(qv[j].x * rstd * gv.x, qv[j].y * rstd * gv.y); } }
            const bool prompt = m < NPR; const int ms = m - NPR;
            const size_t kvrow = prompt ? (size_t)m : (size_t)NPR + (size_t)(ms >> 12) * 4608 + 512 + (ms & 4095);
            { const float rstd = rsqrtf(ssk * (1.f / 256.f) + EPS); const f32x4 gv = *(const f32x4*)(kvng + 4 * lane); const f32x4 ck = kv * rstd * gv;
              if (prompt) *(f32x4*)(p.out + OFF_CKV + (size_t)m * 256 + 4 * lane) = ck;
              u32x2 w; w.x = cvtpk(ck.x, ck.y); w.y = cvtpk(ck.z, ck.w); *(u32x2*)(CKV + kvrow * 256 + 4 * lane) = w; }
            { float outv = kr;
              if (prompt) p.out[OFF_KR + (size_t)m * 64 + lane] = kr;
              const float other = __shfl_xor(kr, 16);
              if (!prompt) { const int t = ms & 4095, half = lane >> 5, idx = lane & 31, fi = idx & 15, hi2 = idx >> 4; const int pos = half ? (t & 63) : (t >> 6);
                  const f32x2 cs = tab[pos * 16 + fi]; const float x1 = hi2 ? other : kr, x2 = hi2 ? kr : other; outv = hi2 ? (x1 * cs.y + x2 * cs.x) : (x1 * cs.x - x2 * cs.y); }
              KR[kvrow * 64 + lane] = f2bf(outv); }
        } else {
            const int cm = m - MROWS, b = cm >> 9, l = cm & 511; const size_t kvrow = (size_t)NPR + (size_t)b * 4608 + l;
            const f32x4 ck = __builtin_nontemporal_load((const f32x4*)(p.in[I_CCKV] + ((size_t)b * 512 + l) * 256 + 4 * lane));
            u32x2 w; w.x = cvtpk(ck.x, ck.y); w.y = cvtpk(ck.z, ck.w); *(u32x2*)(CKV + kvrow * 256 + 4 * lane) = w;
            KR[kvrow * 64 + lane] = f2bf(p.in[I_CKR][((size_t)b * 512 + l) * 64 + lane]);
        }
    }
}

__device__ __forceinline__ void final_norm_phase(const Params& p, int gwb, int nwb, int lo0, int hi0, int lo1, int hi1) {
    const int lane = threadIdx.x & 63, wave = threadIdx.x >> 6;
    const int gw = gwb * NWAVES + wave, NGW = nwb * NWAVES, n0_ = hi0 - lo0, total = n0_ + (hi1 - lo1);
    const float* g = p.in[I_FING]; const bf16_t* X2 = (const bf16_t*)(p.ws + WS_X2B);
    f32x4 gv[4];
#pragma unroll
    for (int j = 0; j < 4; ++j) gv[j] = *(const f32x4*)(g + 4 * lane + 256 * j);
    for (int i0 = gw; i0 < total; i0 += 2 * NGW) {
        const bool has1 = i0 + NGW < total; const int i1 = has1 ? i0 + NGW : i0;
        const int m0 = i0 < n0_ ? lo0 + i0 : lo1 + (i0 - n0_), m1 = i1 < n0_ ? lo0 + i1 : lo1 + (i1 - n0_);
        f32x4 v0[4], v1[4];
#pragma unroll
        for (int j = 0; j < 4; ++j) { const int c = 4 * lane + 256 * j; v0[j] = ld_row4(nullptr, X2 + (size_t)m0 * DM, c); v1[j] = ld_row4(nullptr, X2 + (size_t)m1 * DM, c); }
        float s0 = 0.f, s1 = 0.f;
#pragma unroll
        for (int j = 0; j < 4; ++j) { s0 += (v0[j].x * v0[j].x + v0[j].y * v0[j].y) + (v0[j].z * v0[j].z + v0[j].w * v0[j].w); s1 += (v1[j].x * v1[j].x + v1[j].y * v1[j].y) + (v1[j].z * v1[j].z + v1[j].w * v1[j].w); }
#pragma unroll
        for (int o = 1; o < 64; o <<= 1) { s0 += __shfl_xor(s0, o); s1 += __shfl_xor(s1, o); }
        const float r0 = rsqrtf(s0 * (1.f / DM) + EPS), r1 = rsqrtf(s1 * (1.f / DM) + EPS);
#pragma unroll
        for (int j = 0; j < 4; ++j) { const int c = 4 * lane + 256 * j;
            __builtin_nontemporal_store((v0[j] * r0) * gv[j], (f32x4*)(p.out + (size_t)m0 * DM + c)); if (has1) __builtin_nontemporal_store((v1[j] * r1) * gv[j], (f32x4*)(p.out + (size_t)m1 * DM + c)); }
    }
}

#define XB_TMO      128
#define XB_XCNT(j)  (256  + 64 * (j))
#define XB_XSUB(j)  (1280 + 64 * (j))
#define XB_XGEN(j)  (2304 + 64 * (j))
#define XB_TOP      3328
#define XB_TOPGEN   3392
#define XCD_BAR_WORDS 3456
#define XB_SPIN_CAP (1u << 18)

__device__ __forceinline__ unsigned xb_ld(unsigned* p)              { return __hip_atomic_load(p, __ATOMIC_RELAXED, __HIP_MEMORY_SCOPE_AGENT); }
__device__ __forceinline__ unsigned xb_add(unsigned* p, unsigned v) { return __hip_atomic_fetch_add(p, v, __ATOMIC_RELAXED, __HIP_MEMORY_SCOPE_AGENT); }
__device__ __forceinline__ unsigned xb_xcc_id() { return (unsigned)__builtin_amdgcn_s_getreg((3 << 11) | 20) & 0xFu; }
#define XB_SPIN(cond, bar) do { unsigned _sp = 0; while (cond) { __builtin_amdgcn_s_sleep(1); \
    if ((++_sp & 255u) == 0u) { if (xb_ld(&(bar)[XB_TMO])) break; if (_sp > XB_SPIN_CAP) { atomicAdd(&(bar)[XB_TMO], 1u); break; } } } } while (0)

struct XcdBarrier {
    unsigned* bar; unsigned x;
    volatile LAS unsigned* st;
};

__device__ __forceinline__ XcdBarrier xcd_barrier_post(unsigned* bar, volatile LAS unsigned* st) {
    XcdBarrier b; b.bar = bar; b.x = xb_xcc_id(); b.st = st;
    if (threadIdx.x == 0) (void)xb_add(&bar[XB_XCNT(b.x)], 1u);
    return b;
}
__device__ __forceinline__ void xcd_barrier_complete(unsigned* bar, unsigned x, unsigned& nloc, unsigned& nx) {
    const unsigned G = gridDim.x * gridDim.y * gridDim.z;
    unsigned sum, cnt, mine, sp = 0u;
    for (;;) {
        sum = 0u; cnt = 0u; mine = 0u;
#pragma unroll
        for (unsigned j = 0; j < 16; ++j) { const unsigned c = xb_ld(&bar[XB_XCNT(j)]); sum += c; cnt += (c > 0u) ? 1u : 0u; mine = (j == x) ? c : mine; }
        if (sum == G) break;
        __builtin_amdgcn_s_sleep(1);
        if ((++sp & 255u) == 0u) { if (xb_ld(&bar[XB_TMO])) break; if (sp > XB_SPIN_CAP) { atomicAdd(&bar[XB_TMO], 1u); break; } }
    }
    nloc = mine > 0u ? mine : 1u; nx = cnt > 0u ? cnt : 1u;
}

__device__ __forceinline__ void xcd_barrier(const XcdBarrier& b) {
    asm volatile("s_waitcnt vmcnt(0)" ::: "memory");
    __syncthreads();
    if (threadIdx.x == 0) {
        unsigned* bar = b.bar;
        __builtin_amdgcn_s_waitcnt(0);
        unsigned nloc = b.st[0], nx = b.st[1];
        if (nloc == 0u) { xcd_barrier_complete(bar, b.x, nloc, nx); b.st[0] = nloc; b.st[1] = nx; }
        const unsigned old = xb_add(&bar[XB_XSUB(b.x)], 1u);
        const unsigned gen = old / nloc;
        if (old + 1u == (gen + 1u) * nloc) {
            __builtin_amdgcn_fence(__ATOMIC_RELEASE, "agent");
            asm volatile("s_waitcnt vmcnt(0)" ::: "memory");
            const unsigned og = xb_add(&bar[XB_TOP], 1u);
            const unsigned tg = og / nx;
            if (og + 1u == (tg + 1u) * nx) xb_add(&bar[XB_TOPGEN], 1u);
            else XB_SPIN(xb_ld(&bar[XB_TOPGEN]) == tg, bar);
            __builtin_amdgcn_fence(__ATOMIC_ACQUIRE, "agent");
            xb_add(&bar[XB_XGEN(b.x)], 1u);
            asm volatile("s_waitcnt vmcnt(0)" ::: "memory");
        } else {
            XB_SPIN(xb_ld(&bar[XB_XGEN(b.x)]) == gen, bar);
            __builtin_amdgcn_fence(__ATOMIC_ACQUIRE, "agent");
            asm volatile("s_waitcnt vmcnt(0)" ::: "memory");
        }
    }
    __syncthreads();
}

namespace att {
constexpr int NW = 8, QBLK = 32, KVBLK = 64;
constexpr float SCALE = 0.07216878364870322f;
constexpr float THR = 8.f;
constexpr int SDEPTH = 1;
constexpr int LDQ = 1536, LDK = 2048, LDR = 64, LDO = 1024;
constexpr int SHM_V = KVBLK * 128 * 2, SHM_K = KVBLK * 192 * 2;
constexpr int NQR = 6;
constexpr int SHM_ATTN = 2 * SHM_V + 2 * SHM_K + NW * 64 * 4 + NW * (12 - NQR) * 1024;
#define KSWZ(row, colB) ((row) * 384 + ((colB) ^ (((row) & 7) << 4)))
#define SBAR() __builtin_amdgcn_sched_barrier(0)
__device__ __forceinline__ unsigned cvtpk_a(float lo, float hi) { unsigned r; asm volatile("v_cvt_pk_bf16_f32 %0, %1, %2" : "=v"(r) : "v"(lo), "v"(hi)); return r; }

__device__ __forceinline__ void partialSM(f32x16& p0, f32x16& p1, float& m_reg, float& mn, float& alpha) {
  constexpr float C = SCALE * 1.4426950408889634f;
  float pmax = p0[0];
#pragma unroll
  for (int r = 1; r < 16; ++r) pmax = fmaxf(pmax, p0[r]);
#pragma unroll
  for (int r = 0; r < 16; ++r) pmax = fmaxf(pmax, p1[r]);
  { auto rr = __builtin_amdgcn_permlane32_swap(__float_as_uint(pmax), __float_as_uint(pmax), false, false);
    pmax = fmaxf(__uint_as_float(rr[0]), __uint_as_float(rr[1])); }
  if (__builtin_expect(__all(pmax - m_reg <= THR / SCALE), 1)) { mn = m_reg; alpha = 1.f; }
  else { mn = fmaxf(m_reg, pmax); alpha = __builtin_amdgcn_exp2f((m_reg - mn) * C); m_reg = mn; }
  float mnC = -mn * C;
#pragma unroll
  for (int r = 0; r < 16; ++r) p0[r] = fmaf(p0[r], C, mnC);
#pragma unroll
  for (int r = 0; r < 16; ++r) p1[r] = fmaf(p1[r], C, mnC);
#pragma unroll
  for (int r = 0; r < 16; ++r) p0[r] = __builtin_amdgcn_exp2f(p0[r]);
}
__device__ __forceinline__ void finishSM(f32x16& p0, f32x16& p1, float alpha, float& l_reg, bf16x8& pa0, bf16x8& pa1, bf16x8& pa2, bf16x8& pa3) {
#pragma unroll
  for (int r = 0; r < 16; ++r) p1[r] = __builtin_amdgcn_exp2f(p1[r]);
  float ps = 0;
#pragma unroll
  for (int r = 0; r < 16; ++r) ps += p0[r];
#pragma unroll
  for (int r = 0; r < 16; ++r) ps += p1[r];
  { auto rr = __builtin_amdgcn_permlane32_swap(__float_as_uint(ps), __float_as_uint(ps), false, false);
    ps = __uint_as_float(rr[0]) + __uint_as_float(rr[1]); }
  l_reg = l_reg * alpha + ps;
#define PK4(P, BASE, OUT) do { unsigned a0 = cvtpk_a(P[BASE + 0], P[BASE + 1]), a1 = cvtpk_a(P[BASE + 2], P[BASE + 3]);   \
    unsigned b0 = cvtpk_a(P[BASE + 4], P[BASE + 5]), b1 = cvtpk_a(P[BASE + 6], P[BASE + 7]);                              \
    auto r0 = __builtin_amdgcn_permlane32_swap(a0, b0, false, false); auto r1 = __builtin_amdgcn_permlane32_swap(a1, b1, false, false); \
    u32x4 w = {r0[0], r1[0], r0[1], r1[1]}; OUT = *reinterpret_cast<bf16x8*>(&w); } while (0)
  PK4(p0, 0, pa0); PK4(p0, 8, pa1); PK4(p1, 0, pa2); PK4(p1, 8, pa3);
#undef PK4
}
__device__ __forceinline__ void qkt(f32x16& p0, f32x16& p1, const char* Ks, const bf16x8* qr, const char* qlds, int r32, int hi) {
  p0 = f32x16{}; p1 = f32x16{};
#pragma unroll
  for (int d0 = 0; d0 < 12; ++d0) { int cb = (d0 * 16 + hi * 8) * 2;
    bf16x8 b0 = *reinterpret_cast<const bf16x8*>(Ks + KSWZ(r32, cb));
    bf16x8 b1 = *reinterpret_cast<const bf16x8*>(Ks + KSWZ(32 + r32, cb));
    const bf16x8 qf = d0 < NQR ? qr[d0 < NQR ? d0 : 0] : *reinterpret_cast<const bf16x8*>(qlds + (d0 - NQR) * 1024);
    p0 = __builtin_amdgcn_mfma_f32_32x32x16_bf16(b0, qf, p0, 0, 0, 0);
    p1 = __builtin_amdgcn_mfma_f32_32x32x16_bf16(b1, qf, p1, 0, 0, 0); }
}
__device__ __forceinline__ int v_st(int k, int c) { const int kk = (k & ~0xC) | ((k & 4) << 1) | ((k & 8) >> 1); return ((kk >> 3) * 4 + (c >> 5)) * 512 + ((kk & 7) * 32 + (c & 31)) * 2; }
__device__ __forceinline__ int v_rd_base(int lane) { return ((lane & 3) << 3) | (((lane >> 2) & 3) << 6) | (((lane >> 4) & 1) << 5) | (((lane >> 5) & 1) << 8); }
constexpr int v_rd_off(int d0, int ks, int half) { return d0 * 512 + ks * 4096 + half * 2048; }
template <int OFF> __device__ __forceinline__ s16x4 tr_read(int vb) {
  s16x4 r; asm volatile("ds_read_b64_tr_b16 %0, %1 offset:%2" : "=&v"(r) : "v"(vb), "i"(OFF) : "memory"); return r;
}
template <int D0> __device__ __forceinline__ void pv_one(f32x16& od, int vb, bf16x8 pa0, bf16x8 pa1, bf16x8 pa2, bf16x8 pa3) {
  const s16x4 l0 = tr_read<v_rd_off(D0, 0, 0)>(vb), h0 = tr_read<v_rd_off(D0, 0, 1)>(vb), l1 = tr_read<v_rd_off(D0, 1, 0)>(vb), h1 = tr_read<v_rd_off(D0, 1, 1)>(vb);
  const s16x4 l2 = tr_read<v_rd_off(D0, 2, 0)>(vb), h2 = tr_read<v_rd_off(D0, 2, 1)>(vb), l3 = tr_read<v_rd_off(D0, 3, 0)>(vb), h3 = tr_read<v_rd_off(D0, 3, 1)>(vb);
  asm volatile("s_waitcnt lgkmcnt(0)" ::: "memory"); SBAR();
#define PK(Lx, Hx) (bf16x8){Lx[0], Lx[1], Lx[2], Lx[3], Hx[0], Hx[1], Hx[2], Hx[3]}
  od = __builtin_amdgcn_mfma_f32_32x32x16_bf16(pa0, PK(l0, h0), od, 0, 0, 0);
  od = __builtin_amdgcn_mfma_f32_32x32x16_bf16(pa1, PK(l1, h1), od, 0, 0, 0);
  od = __builtin_amdgcn_mfma_f32_32x32x16_bf16(pa2, PK(l2, h2), od, 0, 0, 0);
  od = __builtin_amdgcn_mfma_f32_32x32x16_bf16(pa3, PK(l3, h3), od, 0, 0, 0);
#undef PK
}
__device__ __forceinline__ void pv_d0(f32x16* o, int vb, bf16x8 pa0, bf16x8 pa1, bf16x8 pa2, bf16x8 pa3) {
  pv_one<0>(o[0], vb, pa0, pa1, pa2, pa3); pv_one<1>(o[1], vb, pa0, pa1, pa2, pa3); pv_one<2>(o[2], vb, pa0, pa1, pa2, pa3); pv_one<3>(o[3], vb, pa0, pa1, pa2, pa3);
}

constexpr int NSLOT = 3, LDS_KR = 0, LDS_VR = NSLOT * SHM_K, LDS_SC = LDS_VR + NSLOT * SHM_V, LDS_Q11 = LDS_SC + NW * 64 * 4, ATT_LDS = LDS_Q11 + NW * 1024;
#define ATT_WAITBAR(N) asm volatile("s_waitcnt vmcnt(" #N ") lgkmcnt(0)\n\ts_barrier" ::: "memory")
__device__ __forceinline__ void qkt3(f32x16& p0, f32x16& p1, const LAS char* Ks, const bf16x8* qr, int baseN, int XN, int baseR, int XR) {
  p0 = f32x16{}; p1 = f32x16{};
#pragma unroll
  for (int d0 = 0; d0 < 8; ++d0) { const int ad = baseN + ((32 * d0) ^ XN);
    bf16x8 b0 = *reinterpret_cast<const LAS bf16x8*>(Ks + ad);
    bf16x8 b1 = *reinterpret_cast<const LAS bf16x8*>(Ks + ad + 8192);
    p0 = __builtin_amdgcn_mfma_f32_32x32x16_bf16(b0, qr[d0], p0, 0, 0, 0);
    p1 = __builtin_amdgcn_mfma_f32_32x32x16_bf16(b1, qr[d0], p1, 0, 0, 0); }
#pragma unroll
  for (int d0 = 8; d0 < 12; ++d0) { const int ad = baseR + ((32 * (d0 - 8)) ^ XR);
    bf16x8 b0 = *reinterpret_cast<const LAS bf16x8*>(Ks + ad);
    bf16x8 b1 = *reinterpret_cast<const LAS bf16x8*>(Ks + ad + 4096);
    p0 = __builtin_amdgcn_mfma_f32_32x32x16_bf16(b0, qr[d0], p0, 0, 0, 0);
    p1 = __builtin_amdgcn_mfma_f32_32x32x16_bf16(b1, qr[d0], p1, 0, 0, 0); }
}
#define LDK128(dst, addr, OFFS) asm volatile("ds_read_b128 %0, %1 offset:%2" : "=&v"(dst) : "v"(addr), "n"(OFFS) : "memory")
#define LWAIT0() asm volatile("s_waitcnt lgkmcnt(0)" ::: "memory")
#define KAD(d0) ((d0) < 8 ? (unsigned)(ksl + baseN + ((32 * (d0)) ^ XN)) : (unsigned)(ksl + baseR + ((32 * ((d0) - 8)) ^ XR)))
#define KISSUE(F, j0) do { _Pragma("unroll") for (int t_ = 0; t_ < 3; ++t_) { const unsigned ad_ = KAD((j0) + t_); \
    if ((j0) + t_ < 8) { LDK128(F[2 * t_], ad_, 0); LDK128(F[2 * t_ + 1], ad_, 8192); } else { LDK128(F[2 * t_], ad_, 0); LDK128(F[2 * t_ + 1], ad_, 4096); } } } while (0)
#define KMFMA(F, j0) do { _Pragma("unroll") for (int t_ = 0; t_ < 3; ++t_) { \
    p0 = __builtin_amdgcn_mfma_f32_32x32x16_bf16(F[2 * t_], qr[(j0) + t_], p0, 0, 0, 0); p1 = __builtin_amdgcn_mfma_f32_32x32x16_bf16(F[2 * t_ + 1], qr[(j0) + t_], p1, 0, 0, 0); } } while (0)
#define QK_HEAD(FA) KISSUE(FA, 0)
#define QK_BODY(FA, FB) do { p0 = f32x16{}; p1 = f32x16{}; \
    SBAR(); LWAIT0(); KISSUE(FB, 3); SBAR(); KMFMA(FA, 0); \
    SBAR(); LWAIT0(); KISSUE(FA, 6); SBAR(); KMFMA(FB, 3); \
    SBAR(); LWAIT0(); KISSUE(FB, 9); SBAR(); KMFMA(FA, 6); \
    SBAR(); LWAIT0(); SBAR(); KMFMA(FB, 9); SBAR(); } while (0)
#define VISSUE(Lx, Hx, D0) do { Lx[0] = tr_read<v_rd_off(D0, 0, 0)>(vb); Hx[0] = tr_read<v_rd_off(D0, 0, 1)>(vb); Lx[1] = tr_read<v_rd_off(D0, 1, 0)>(vb); Hx[1] = tr_read<v_rd_off(D0, 1, 1)>(vb); \
    Lx[2] = tr_read<v_rd_off(D0, 2, 0)>(vb); Hx[2] = tr_read<v_rd_off(D0, 2, 1)>(vb); Lx[3] = tr_read<v_rd_off(D0, 3, 0)>(vb); Hx[3] = tr_read<v_rd_off(D0, 3, 1)>(vb); } while (0)
#define VPK(Lx, Hx, i) (bf16x8){Lx[i][0], Lx[i][1], Lx[i][2], Lx[i][3], Hx[i][0], Hx[i][1], Hx[i][2], Hx[i][3]}
#define VMFMA(od, Lx, Hx) do { od = __builtin_amdgcn_mfma_f32_32x32x16_bf16(pa0, VPK(Lx, Hx, 0), od, 0, 0, 0); od = __builtin_amdgcn_mfma_f32_32x32x16_bf16(pa1, VPK(Lx, Hx, 1), od, 0, 0, 0); \
    od = __builtin_amdgcn_mfma_f32_32x32x16_bf16(pa2, VPK(Lx, Hx, 2), od, 0, 0, 0); od = __builtin_amdgcn_mfma_f32_32x32x16_bf16(pa3, VPK(Lx, Hx, 3), od, 0, 0, 0); } while (0)
__device__ __forceinline__ void attn_unit(const bf16_t* __restrict__ Qb, const bf16_t* __restrict__ Kn, const bf16_t* __restrict__ Vh, const bf16_t* __restrict__ Kr,
                                          const bf16_t* Gi, bf16_t* Go, int seq, LAS unsigned char* L, const f32x2* __restrict__ tab, int t0) {
  const int tid = threadIdx.x, wid = __builtin_amdgcn_readfirstlane(tid >> 6), lane = tid & 63, r32 = lane & 31, hi = lane >> 5;
  const LAS char* K_lds = (const LAS char*)L + LDS_KR;
  LAS float* ws = (LAS float*)(L + LDS_SC) + wid * 64; LAS float* li_l = ws; LAS float* al_l = ws + 32;
  const char* kp[3]; int kst[3]; const char* vp[2];
#pragma unroll
  for (int i = 0; i < 2; ++i) { const int o = (wid + 8 * i) * 1024 + lane * 16, row = o >> 8, s = (o >> 4) & 15, c4 = s ^ ((row & 7) | (((row >> 4) & 1) << 3));
    kp[i] = (const char*)(Kn + (long)row * LDK + c4 * 8); kst[i] = KVBLK * LDK * 2; }
  { const int o = wid * 1024 + lane * 16, line = o >> 8, s = (o >> 4) & 15, row = 32 * (line >> 4) + 16 * (s >> 3) + (line & 15), c4 = (s & 7) ^ (row & 7);
    kp[2] = (const char*)(Kr + (long)row * LDR + c4 * 8); kst[2] = KVBLK * LDR * 2; }
  const int gq = (r32 & 7) | (((r32 >> 4) & 1) << 3);
  const int baseN = r32 * 256, XN = 16 * (hi ^ gq), baseR = 16384 + (r32 & 15) * 256 + 128 * ((r32 >> 4) & 1), XR = 16 * (hi ^ (r32 & 7));
#pragma unroll
  for (int i = 0; i < 2; ++i) { const int o = (wid + 8 * i) * 1024 + lane * 16, sub = o >> 9, kk = (sub >> 2) * 8 + ((o & 511) >> 6), c = (sub & 3) * 32 + ((o & 63) >> 1);
    const int k = (kk & ~0xC) | ((kk & 4) << 1) | ((kk & 8) >> 1); vp[i] = (const char*)(Vh + (long)k * LDK + c); }
#define DMA_K(slot) do { _Pragma("unroll") for (int i_ = 0; i_ < 3; ++i_) { __builtin_amdgcn_global_load_lds((const unsigned*)kp[i_], (LAS unsigned*)(L + LDS_KR + (slot) * SHM_K + (wid + 8 * i_) * 1024), 16, 0, 0); kp[i_] += kst[i_]; } } while (0)
#define DMA_V(slot) do { _Pragma("unroll") for (int i_ = 0; i_ < 2; ++i_) { __builtin_amdgcn_global_load_lds((const unsigned*)vp[i_], (LAS unsigned*)(L + LDS_VR + (slot) * SHM_V + (wid + 8 * i_) * 1024), 16, 0, 0); vp[i_] += KVBLK * LDK * 2; } } while (0)
  const int NT = seq / KVBLK;
  DMA_K(0); DMA_V(0); DMA_K(1); DMA_V(1);
  float m_reg = -1e30f, l_reg = 0; f32x16 o[4] = {}; bf16x8 qr[12];
  const bf16_t* Qw = Qb + (long)(wid * QBLK + r32) * LDQ + hi * 8;
#pragma unroll
  for (int d0 = 0; d0 < 8; ++d0) qr[d0] = *reinterpret_cast<const bf16x8*>(Qw + d0 * 16);
  {
    u32x4 qp[4];
#pragma unroll
    for (int d0 = 0; d0 < 4; ++d0) qp[d0] = *reinterpret_cast<const u32x4*>(Qw + 128 + d0 * 16);
    if (t0 >= 0) { const int t = t0 + wid * QBLK + r32;
#pragma unroll
      for (int pr = 0; pr < 2; ++pr) { const int pos = pr == 0 ? (t >> 6) : (t & 63); const f32x2* tp = tab + pos * 16 + hi * 8;
#pragma unroll
        for (int e2 = 0; e2 < 4; ++e2) { const f32x2 c0 = tp[2 * e2], c1 = tp[2 * e2 + 1];
          const float a0 = bflo(qp[2 * pr][e2]), a1 = bfhi(qp[2 * pr][e2]), b0 = bflo(qp[2 * pr + 1][e2]), b1 = bfhi(qp[2 * pr + 1][e2]);
          qp[2 * pr][e2] = cvtpk(a0 * c0.x - b0 * c0.y, a1 * c1.x - b1 * c1.y); qp[2 * pr + 1][e2] = cvtpk(a0 * c0.y + b0 * c0.x, a1 * c1.y + b1 * c1.x); } } }
#pragma unroll
    for (int d0 = 0; d0 < 3; ++d0) qr[8 + d0] = __builtin_bit_cast(bf16x8, qp[d0]);
    *(LAS u32x4*)(L + LDS_Q11 + wid * 1024 + lane * 16) = qp[3]; }
  const int vb0 = (int)(unsigned)(uintptr_t)(L + LDS_VR) + v_rd_base(lane);
#define RESC(a) do { if (__any((a) < 1.f)) { if (hi == 0) al_l[r32] = (a); asm volatile("s_waitcnt lgkmcnt(0)" ::: "memory"); \
    _Pragma("unroll") for (int d = 0; d < 4; ++d) _Pragma("unroll") for (int r = 0; r < 16; ++r) o[d][r] *= al_l[crow(r, hi)]; } } while (0)
  ATT_WAITBAR(0);
  if (wid >= 4) ATT_WAITBAR(0);
  int sj = 0;
#pragma unroll 1
  for (int j = 0; j < NT; ++j) {
    f32x16 p0, p1; float mnC, alC;
    {
      const unsigned ksl = (unsigned)(uintptr_t)(K_lds + sj * SHM_K);
      bf16x8 FA[6], FB[6];
      qr[11] = *(const LAS bf16x8*)(L + LDS_Q11 + wid * 1024 + lane * 16);
      QK_HEAD(FA);
      QK_BODY(FA, FB);
      partialSM(p0, p1, m_reg, mnC, alC);
      RESC(alC); }
    ATT_WAITBAR(0);
    {
      const int vb = vb0 + sj * SHM_V;
      s16x4 LA[4], HA[4], LB[4], HB[4]; bf16x8 pa0, pa1, pa2, pa3;
      VISSUE(LA, HA, 0);
      if (j + 2 < NT) { const int s2 = sj == 0 ? 2 : sj - 1; DMA_V(s2); DMA_K(s2); }
      SBAR(); finishSM(p0, p1, alC, l_reg, pa0, pa1, pa2, pa3); SBAR();
      LWAIT0(); VISSUE(LB, HB, 1); SBAR(); VMFMA(o[0], LA, HA);
      SBAR(); LWAIT0(); VISSUE(LA, HA, 2); SBAR(); VMFMA(o[1], LB, HB);
      SBAR(); LWAIT0(); VISSUE(LB, HB, 3); SBAR(); VMFMA(o[2], LA, HA);
      SBAR(); LWAIT0(); SBAR(); VMFMA(o[3], LB, HB); }
    if (j + 2 < NT) ATT_WAITBAR(5); else ATT_WAITBAR(0);
    sj = sj == 2 ? 0 : sj + 1;
  }
  if (wid < 4) ATT_WAITBAR(0);
  if (hi == 0) li_l[r32] = l_reg; asm volatile("s_waitcnt lgkmcnt(0)" ::: "memory");
  unsigned stg_a = (unsigned)(uintptr_t)(L + wid * 8192); asm volatile("" : "+v"(stg_a));
  int lane_e = lane; asm volatile("" : "+v"(lane_e));
  LAS char* stg = (LAS char*)(uintptr_t)(stg_a + (unsigned)(((lane_e >> 5) * 4 * 128 + (lane_e & 31)) * 2));
#pragma unroll
  for (int r = 0; r < 16; ++r) { const float rl = __builtin_amdgcn_rcpf(li_l[crow(r, hi)]);
#pragma unroll
    for (int d0 = 0; d0 < 4; ++d0) *(LAS bf16_t*)(stg + ((r & 3) + 8 * (r >> 2)) * 256 + d0 * 64) = f2bf(o[d0][r] * rl); }
  stg = (LAS char*)(uintptr_t)stg_a;
  asm volatile("s_waitcnt lgkmcnt(0)" ::: "memory");
  { const bf16_t* Gw = Gi + (long)(wid * QBLK) * LDO; bf16_t* Ow = Go + (long)(wid * QBLK) * LDO;
#pragma unroll 1
    for (int ib_ = 0; ib_ < 2; ++ib_) {
      u32x4 gt[4];
#pragma unroll
      for (int i = 0; i < 4; ++i) { const int n = lane + 64 * (4 * ib_ + i); gt[i] = *(const u32x4*)(Gw + (long)(n >> 4) * LDO + (n & 15) * 8); }
#pragma unroll
      for (int i = 0; i < 4; ++i) { const int n = lane + 64 * (4 * ib_ + i); const u32x4 ov = *(const LAS u32x4*)(stg + n * 16); const u32x4 g = gt[i]; u32x4 w;
        w.x = cvtpk(bflo(ov.x) * silu_f(bflo(g.x)), bfhi(ov.x) * silu_f(bfhi(g.x))); w.y = cvtpk(bflo(ov.y) * silu_f(bflo(g.y)), bfhi(ov.y) * silu_f(bfhi(g.y)));
        w.z = cvtpk(bflo(ov.z) * silu_f(bflo(g.z)), bfhi(ov.z) * silu_f(bfhi(g.z))); w.w = cvtpk(bflo(ov.w) * silu_f(bflo(g.w)), bfhi(ov.w) * silu_f(bfhi(g.w)));
        *(u32x4*)(Ow + (long)(n >> 4) * LDO + (n & 15) * 8) = w; } } }
  asm volatile("s_waitcnt vmcnt(0) lgkmcnt(0)\n\ts_barrier" ::: "memory");
#undef DMA_K
#undef DMA_V
#undef RESC
#undef ROT
#undef STEP
}
#undef SBAR
}

__device__ __forceinline__ void attn_phase(const Params& p, LAS unsigned char* lds, int G, bool dummy) {
    const bf16_t* Q = (const bf16_t*)(p.ws + WS_LATQ); const bf16_t* KV = (const bf16_t*)(p.ws + WS_KV); const bf16_t* KR = (const bf16_t*)(p.ws + WS_KR); bf16_t* GT = (bf16_t*)(p.ws + WS_GATE);
    for (int u = blockIdx.x; u < 1280; u += G) {
        size_t qrow, krow; int hh, seq, t0;
        if (u < 1024) { const int v = u & 255, k = u >> 8, xcd = v & 7, idx = v >> 3; const int bh = k * 16 + xcd * 2 + (idx >> 4), qb = idx & 15; const int b = bh >> 3; hh = bh & 7;
            qrow = (size_t)NPR + (size_t)b * 4096 + (size_t)qb * 256; krow = (size_t)NPR + (size_t)b * 4608; seq = 4608; t0 = qb * 256; }
        else { const int pu = u - 1024; const int b = pu >> 3; hh = pu & 7; qrow = (size_t)b * 256; krow = qrow; seq = 256; t0 = -1; }
        att::attn_unit(Q + qrow * 1536 + hh * 192, KV + krow * 2048 + hh * 256, KV + krow * 2048 + hh * 256 + 128, KR + krow * 64, GT + qrow * 1024 + hh * 128, dummy ? (bf16_t*)(p.ws + WS_ACT + 64 * MiB) : GT + qrow * 1024 + hh * 128, seq, lds, (const f32x2*)(p.ws + WS_TAB), t0);
    }
}

#ifndef MK_SINGLE
#define MK_SINGLE 1
#endif
constexpr int N_PHASES = 14;
struct KArgs { Params p; int ph_lo, ph_hi; };

__global__ void __launch_bounds__(NTHREADS, 2) mk_fwd(KArgs a) {
    extern __shared__ __attribute__((aligned(16))) unsigned char lds[];
    cg::grid_group grid = cg::this_grid();
    const Params& p = a.p; const int G = gridDim.x;
    LAS char* L = (LAS char*)lds;
    volatile LAS unsigned* MISC = (volatile LAS unsigned*)((LAS unsigned char*)lds + 147456 - 128);
    if (threadIdx.x < 16) MISC[threadIdx.x] = 0u;
    if (blockIdx.x == 0) { unsigned* bw = (unsigned*)(p.ws + WS_BAR);
        for (int i = threadIdx.x; i < XCD_BAR_WORDS; i += NTHREADS) __hip_atomic_store(bw + i, 0u, __ATOMIC_RELAXED, __HIP_MEMORY_SCOPE_AGENT);
        asm volatile("s_waitcnt vmcnt(0)" ::: "memory"); }
    __syncthreads();
    XcdBarrier bar; bar.bar = (unsigned*)(p.ws + WS_BAR); bar.x = 0; bar.st = MISC + 8;
    unsigned char* ws = p.ws;
    float* mod = (float*)(ws + WS_MOD);
    bf16_t* ACT = (bf16_t*)(ws + WS_ACT);
#ifndef PH
#define PH -1
#endif
#define IN(k) ((PH < 0 || PH == (k)) && a.ph_lo <= (k) && (k) < a.ph_hi)
#ifndef DUPMASK
#define DUPMASK 0
#endif
#define DUP(k) (((DUPMASK) >> (k)) & 1)
#define SEAM(k) do { if (a.ph_lo <= (k) && (k) + 1 < a.ph_hi) { if ((k) == 0) grid.sync(); else xcd_barrier(bar); } } while (0)
#define RUN_GEMM(EPI, Aptr, Bptr, M_, N_, K_, ...) do { pg8::Gemm g{(const bf16_t*)(Aptr), (const bf16_t*)(Bptr), (M_), (N_), (K_)}; pg8::StaticOrder S; S.init((M_), (N_), G, (int)blockIdx.x); \
        pg8::EPI E{__VA_ARGS__}; pg8::gemm_phase<pg8::EPI, pg8::StaticOrder, true, true>((PG8_LAS unsigned char*)lds, g, S, E); } while (0)

#ifdef NSYNC_EXTRA
    for (int i_ = 0; i_ < NSYNC_EXTRA; ++i_) grid.sync();
#endif
    if (IN(0)) { if (DUP(0)) { p0_phase(p, L, G); grid.sync(); } p0_phase(p, L, G); }
    SEAM(0);
    if (a.ph_lo <= 0 && 1 < a.ph_hi) bar = xcd_barrier_post((unsigned*)(p.ws + WS_BAR), MISC + 8);
    if (IN(1)) norm_mod_phase(p.in[I_XP], p.in[I_XS], nullptr, p.in[I_NORMG], mod, ACT, (int)blockIdx.x, G, 0, MROWS, 0, 0);
    SEAM(1);
    if (IN(2)) { if (DUP(2)) { RUN_GEMM(EpiBf16S, ACT, ws + WS_W_EIN, MROWS, 4096, 1024, (bf16_t*)(ws + WS_P), PP, 2, 4, 0.08838834764831845f, 1 << 30, nullptr, 0, 8, 2048); grid.sync(); } RUN_GEMM(EpiBf16S, ACT, ws + WS_W_EIN, MROWS, 4096, 1024, (bf16_t*)(ws + WS_P), PP, 2, 4, 0.08838834764831845f, 1 << 30, nullptr, 0, 8, 2048); }
    SEAM(2);
    if (IN(3)) ret_local_phase(p, L, G);
    SEAM(3);
    if (IN(4)) ret_scan2_phase(p, G);
    SEAM(4);
    if (IN(5)) { if (DUP(5)) { ret_out_phase(p, L, G); grid.sync(); } ret_out_phase(p, L, G); }
    SEAM(5);
#define RUN_PART(PM0, MSUB, GS, XP_, XS_, B16_, O16_, MODL_, Aptr, Bptr) do { pg8::Gemm g{(const bf16_t*)(Aptr) + (size_t)(PM0) * 256 * 1024, (const bf16_t*)(Bptr), (MSUB), 1024, 1024}; \
        pg8::StaticOrder S; S.init((MSUB), 1024, (GS), (int)blockIdx.x); pg8::EpiRes E{(XP_), (XS_), (B16_), (O16_), (MODL_), (PM0)}; \
        pg8::gemm_phase<pg8::EpiRes, pg8::StaticOrder, true, true>((PG8_LAS unsigned char*)lds, g, S, E); } while (0)
#define RUN_SPLIT(XP_, XS_, B16_, O16_, MODL_, Aptr, Bptr, OTHER) do { \
        RUN_PART(0, 32768, G, XP_, XS_, B16_, O16_, MODL_, Aptr, Bptr); \
        xcd_barrier(bar); \
        { const int Gs = G >> 1; if ((int)blockIdx.x < Gs) RUN_PART(128, MROWS - 32768, Gs, XP_, XS_, B16_, O16_, MODL_, Aptr, Bptr); else { OTHER; } } } while (0)
    if (IN(6)) RUN_SPLIT(p.in[I_XP], p.in[I_XS], nullptr, (bf16_t*)p.out, mod, ACT, ws + WS_W_EOUT,
                         norm_mod_phase(nullptr, nullptr, (const bf16_t*)p.out, p.in[I_NORMG] + DM, mod + 9 * 3072, ACT, (int)blockIdx.x - Gs, G - Gs, 0, 32768, 0, 0));
    SEAM(6);
    if (IN(7)) norm_mod_phase(nullptr, nullptr, (const bf16_t*)p.out, p.in[I_NORMG] + DM, mod + 9 * 3072, ACT, (int)blockIdx.x, G, 32768, MROWS, 0, 0);
    SEAM(7);
    if (IN(8)) { if (DUP(8)) { RUN_GEMM(EpiBf16S, ACT, ws + WS_W_OIN, MROWS, 1792, 1024, (bf16_t*)(ws + WS_GATE), 1024, 0, 0, 1.f, 4, (bf16_t*)(ws + WS_LAT16), 768, 1 << 30, 0); grid.sync(); } RUN_GEMM(EpiBf16S, ACT, ws + WS_W_OIN, MROWS, 1792, 1024, (bf16_t*)(ws + WS_GATE), 1024, 0, 0, 1.f, 4, (bf16_t*)(ws + WS_LAT16), 768, 1 << 30, 0); }
    SEAM(8);
    if (IN(9)) { if (DUP(9)) { lat_phase(p, G); grid.sync(); } lat_phase(p, G); }
    SEAM(9);
    if (IN(10)) {
#pragma unroll 1
      for (int rep9 = DUP(10) ? 0 : 1; rep9 < 2; ++rep9) {
        RUN_GEMM(EpiBf16S, ws + WS_QN, ws + WS_W_QUP, MROWS, 1536, 384, (bf16_t*)(ws + WS_LATQ), 1536, 0, 0, 1.f, 1 << 30, nullptr, 0, 1 << 30, 0);
        RUN_GEMM(EpiBf16S, ws + WS_CKV, ws + WS_W_KVUP, KVROWS, 2048, 256, (bf16_t*)(ws + WS_KV), 2048, 0, 0, 1.f, 1 << 30, nullptr, 0, 1 << 30, 0);
        if (rep9 == 0) grid.sync(); }
    }
    SEAM(10);
    if (IN(11)) {
#if DUPMASK & (1 << 11)
#pragma unroll 1
        for (int rep = 0; rep < 2; ++rep) { attn_phase(p, (LAS unsigned char*)lds, G, rep == 0); if (rep == 0) xcd_barrier(bar); }
#else
        attn_phase(p, (LAS unsigned char*)lds, G, false);
#endif
    }
    SEAM(11);
    if (IN(12)) RUN_SPLIT(nullptr, nullptr, (const bf16_t*)p.out, (bf16_t*)(ws + WS_X2B), mod + 9 * 3072, ws + WS_GATE, ws + WS_W_OOUT,
                          final_norm_phase(p, (int)blockIdx.x - Gs, G - Gs, 0, 16384, 20480, 32768));
    SEAM(12);
    if (IN(13)) final_norm_phase(p, (int)blockIdx.x, G, 16384, 20480, 32768, MROWS);
#undef IN
#undef SEAM
#undef RUN_GEMM
}

extern "C" void kernel_launch(void* const* d_in, const int* in_sizes, int n_in, void* d_out, int out_size, void* d_ws, size_t ws_size, hipStream_t stream) {
    static int grid = 0;
    if (grid == 0) {
        if (n_in != 21 || in_sizes[0] != NPR * DM || in_sizes[1] != 32768 * DM || (size_t)out_size != OUT_TOTAL || ws_size < WS_END) {
            fprintf(stderr, "kernel_launch: unexpected shapes: n_in %d in0 %d in1 %d out %d ws %zu (need >= %zu)\n", n_in, n_in > 0 ? in_sizes[0] : -1, n_in > 1 ? in_sizes[1] : -1, out_size, ws_size, (size_t)WS_END);
            grid = -1; return; }
        int dev = 0, cus = 0, per_cu = 0;
        if (hipGetDevice(&dev) != hipSuccess || hipDeviceGetAttribute(&cus, hipDeviceAttributeMultiprocessorCount, dev) != hipSuccess) { fprintf(stderr, "kernel_launch: device query failed\n"); grid = -1; return; }
        if (hipFuncSetAttribute((const void*)mk_fwd, hipFuncAttributeMaxDynamicSharedMemorySize, LDS_BYTES) != hipSuccess) { fprintf(stderr, "kernel_launch: hipFuncSetAttribute failed\n"); grid = -1; return; }
        if (hipOccupancyMaxActiveBlocksPerMultiprocessor(&per_cu, (const void*)mk_fwd, NTHREADS, LDS_BYTES) != hipSuccess || per_cu < 1) { fprintf(stderr, "kernel_launch: occupancy query says %d blocks per CU\n", per_cu); (void)hipGetLastError(); grid = -1; return; }
        grid = cus * per_cu;
    }
    if (grid < 0) return;
    KArgs a{};
    for (int i = 0; i < 21; ++i) a.p.in[i] = (const float*)d_in[i];
    a.p.out = (float*)d_out; a.p.ws = (unsigned char*)d_ws;
#if MK_SINGLE
    a.ph_lo = 0; a.ph_hi = N_PHASES;
    void* args[] = {&a};
    hipError_t e = hipLaunchCooperativeKernel((const void*)mk_fwd, dim3(grid), dim3(NTHREADS), args, LDS_BYTES, stream);
    if (e != hipSuccess) fprintf(stderr, "kernel_launch: cooperative launch failed: %s (grid %d)\n", hipGetErrorString(e), grid);
#else
#ifndef HOSTDUP
#define HOSTDUP -1
#endif
    for (int k = 0; k < N_PHASES; ++k) { a.ph_lo = k; a.ph_hi = k + 1;
        hipLaunchKernelGGL(mk_fwd, dim3(grid), dim3(NTHREADS), LDS_BYTES, stream, a); }
#endif
}
```
